# Optimizing an MI355X kernel written in HIP

```python
import math
import jax, jax.numpy as jnp
from jax import lax
import numpy as np

D_MODEL = 1024
BATCH = 2
SEQ = 8192
DEPTH = 1

HEAD_DIM = 64
N_HEADS = D_MODEL // HEAD_DIM
SB_HEADS = N_HEADS // 2
SWA_HEADS = N_HEADS - SB_HEADS
SWA_KV_HEADS = 2
SWA_GROUP = SWA_HEADS // SWA_KV_HEADS
WINDOW = 128
BLOCK_Q = 128
SB_W = SB_HEADS * HEAD_DIM
SWA_QW = SWA_HEADS * HEAD_DIM
SWA_KW = SWA_KV_HEADS * HEAD_DIM
D_IN = 3 * SB_W + SWA_QW + 2 * SWA_KW
D_FF = ((-(-8 * D_MODEL // 3)) + 255) // 256 * 256
N_MOD = 6
DEEPNORM_ALPHA = (2.0 * DEPTH) ** 0.25
DEEPNORM_BETA = (8.0 * DEPTH) ** -0.25
LN_EPS = 1e-5
RMS_EPS = 1e-6
MASK_VALUE = -1e30

kernel_name = "hymba_stickbreak_swa_sink_deepnorm_adaln"


def layer_norm(x, g, b):
    xf = x.astype(jnp.float32)
    mu = jnp.mean(xf, axis=-1, keepdims=True)
    var = jnp.mean(jnp.square(xf - mu), axis=-1, keepdims=True)
    return ((xf - mu) * lax.rsqrt(var + LN_EPS)).astype(x.dtype) * g + b


def rms_norm(x, g):
    xf = x.astype(jnp.float32)
    ms = jnp.mean(jnp.square(xf), axis=-1, keepdims=True)
    return (xf * lax.rsqrt(ms + RMS_EPS)).astype(x.dtype) * g


def alibi_slopes(n_heads):
    return jnp.exp2(-8.0 * jnp.arange(1, n_heads + 1, dtype=jnp.float32) / n_heads)


def stick_breaking_attention(q, k, v):
    B, S, H, Dh = q.shape
    nblk = S // BLOCK_Q
    scale = 1.0 / math.sqrt(Dh)
    qb = q.reshape(B, nblk, BLOCK_Q, H, Dh).transpose(1, 0, 3, 2, 4)
    kpos = jnp.arange(S)

    def one_block(args):
        qi, i = args
        z = jnp.einsum('bhqd,bshd->bhqs', qi, k).astype(jnp.float32) * scale
        qpos = i * BLOCK_Q + jnp.arange(BLOCK_Q)
        before = kpos[None, :] < qpos[:, None]
        log_beta = jax.nn.log_sigmoid(z)
        log_rem = jnp.where(before, jax.nn.log_sigmoid(-z), 0.0)
        suffix = lax.cumsum(log_rem, axis=3, reverse=True) - log_rem
        w = jnp.where(before, jnp.exp(log_beta + suffix), 0.0)
        return jnp.einsum('bhqs,bshd->bqhd', w.astype(v.dtype), v)

    out = lax.map(one_block, (qb, jnp.arange(nblk)))
    return out.transpose(1, 0, 2, 3, 4).reshape(B, S, H * Dh)


def sliding_window_sink_attention(q, k, v, sinks):
    B, S, Hq, Dh = q.shape
    nblk = S // WINDOW
    qb = q.reshape(B, nblk, WINDOW, SWA_KV_HEADS, SWA_GROUP, Dh)

    def banded(t):
        tb = t.reshape(B, nblk, WINDOW, SWA_KV_HEADS, Dh)
        prev = jnp.pad(tb, ((0, 0), (1, 0), (0, 0), (0, 0), (0, 0)))[:, :-1]
        return jnp.concatenate([prev, tb], axis=2)

    kb, vb = banded(k), banded(v)
    s = jnp.einsum('bnqkgd,bnskd->bnkgqs', qb, kb).astype(jnp.float32) / math.sqrt(Dh)
    qi = jnp.arange(WINDOW)
    kj = jnp.arange(2 * WINDOW)
    dist = (qi[:, None] + WINDOW - kj[None, :]).astype(jnp.float32)
    in_band = (dist >= 0) & (dist < WINDOW)
    key_pos = jnp.arange(nblk)[:, None] * WINDOW - WINDOW + kj[None, :]
    mask = in_band[None, :, :] & (key_pos >= 0)[:, None, :]
    slopes = alibi_slopes(SWA_HEADS).reshape(SWA_KV_HEADS, SWA_GROUP)
    s = s - slopes[None, None, :, :, None, None] * dist[None, None, None, None]
    s = jnp.where(mask[None, :, None, None], s, MASK_VALUE)
    sink = sinks.astype(jnp.float32).reshape(SWA_KV_HEADS, SWA_GROUP)[None, None, :, :, None, None]
    m = jnp.maximum(jnp.max(s, axis=-1, keepdims=True), sink)
    p = jnp.exp(s - m)
    p = p / (jnp.sum(p, axis=-1, keepdims=True) + jnp.exp(sink - m))
    o = jnp.einsum('bnkgqs,bnskd->bnqkgd', p.astype(v.dtype), vb)
    return o.reshape(B, S, Hq * Dh)


def setup_inputs(seed: int = 0) -> dict:
    key = jax.random.key(seed)
    ks = jax.random.split(key, 16)
    f32 = jnp.float32
    nrm = lambda k, shape: jax.random.normal(k, shape, f32)
    return {
        "x": nrm(ks[0], (BATCH, SEQ, D_MODEL)),
        "c": nrm(ks[1], (BATCH, D_MODEL)),
        "w_ada": nrm(ks[2], (DEPTH, D_MODEL, N_MOD * D_MODEL)) * (0.1 * D_MODEL ** -0.5),
        "b_ada": nrm(ks[3], (DEPTH, N_MOD * D_MODEL)) * 0.01,
        "w_in": nrm(ks[4], (DEPTH, D_MODEL, D_IN)) * D_MODEL ** -0.5,
        "b_in": nrm(ks[5], (DEPTH, D_IN)) * 0.01,
        "sinks": nrm(ks[6], (DEPTH, SWA_HEADS)) * 0.5,
        "gn_sb": 1.0 + 0.01 * nrm(ks[7], (DEPTH, SB_W)),
        "gn_swa": 1.0 + 0.01 * nrm(ks[8], (DEPTH, SWA_QW)),
        "w_out": nrm(ks[9], (DEPTH, D_MODEL, D_MODEL)) * (DEEPNORM_BETA * D_MODEL ** -0.5),
        "ln1_g": 1.0 + 0.01 * nrm(ks[10], (DEPTH, D_MODEL)),
        "ln1_b": 0.01 * nrm(ks[11], (DEPTH, D_MODEL)),
        "w_gu": nrm(ks[12], (DEPTH, D_MODEL, 2 * D_FF)) * D_MODEL ** -0.5,
        "w_down": nrm(ks[13], (DEPTH, D_FF, D_MODEL)) * (DEEPNORM_BETA * D_FF ** -0.5),
        "ln2_g": 1.0 + 0.01 * nrm(ks[14], (DEPTH, D_MODEL)),
        "ln2_b": 0.01 * nrm(ks[15], (DEPTH, D_MODEL)),
    }


def reference(x, c, w_ada, b_ada, w_in, b_in, sinks, gn_sb, gn_swa, w_out,
              ln1_g, ln1_b, w_gu, w_down, ln2_g, ln2_b):
    B, S, _ = x.shape
    for l in range(DEPTH):
        mod = jax.nn.silu(c) @ w_ada[l] + b_ada[l]
        sh_a, sc_a, g_a, sh_f, sc_f, g_f = jnp.split(mod[:, None, :], N_MOD, axis=-1)

        h = x * (1.0 + sc_a) + sh_a
        proj = h @ w_in[l] + b_in[l]
        o0, o1, o2, o3, o4 = np.cumsum([SB_W, SB_W, SB_W, SWA_QW, SWA_KW])
        q_sb = proj[..., :o0].reshape(B, S, SB_HEADS, HEAD_DIM)
        k_sb = proj[..., o0:o1].reshape(B, S, SB_HEADS, HEAD_DIM)
        v_sb = proj[..., o1:o2].reshape(B, S, SB_HEADS, HEAD_DIM)
        q_sw = proj[..., o2:o3].reshape(B, S, SWA_HEADS, HEAD_DIM)
        k_sw = proj[..., o3:o4].reshape(B, S, SWA_KV_HEADS, HEAD_DIM)
        v_sw = proj[..., o4:].reshape(B, S, SWA_KV_HEADS, HEAD_DIM)

        y_sb = stick_breaking_attention(q_sb, k_sb, v_sb)
        y_sw = sliding_window_sink_attention(q_sw, k_sw, v_sw, sinks[l])
        mixed = jnp.concatenate([rms_norm(y_sb, gn_sb[l]), rms_norm(y_sw, gn_swa[l])], axis=-1)
        attn = mixed @ w_out[l]
        x = layer_norm(DEEPNORM_ALPHA * x + (1.0 + g_a) * attn, ln1_g[l], ln1_b[l])

        h = x * (1.0 + sc_f) + sh_f
        gate, up = jnp.split(h @ w_gu[l], 2, axis=-1)
        ffn = (jax.nn.silu(gate) * up) @ w_down[l]
        x = layer_norm(DEEPNORM_ALPHA * x + (1.0 + g_f) * ffn, ln2_g[l], ln2_b[l])
    return x
```

```cpp
#include <hip/hip_runtime.h>
#include <hip/hip_cooperative_groups.h>
#include <cstdio>
#include <cstdint>
namespace cg = cooperative_groups;
namespace pg8 {
#define PG8_LAS __attribute__((address_space(3)))
typedef unsigned short bf16_t;
typedef short bf16x8 __attribute__((ext_vector_type(8)));
typedef float f32x4 __attribute__((ext_vector_type(4)));
typedef unsigned u32x4 __attribute__((ext_vector_type(4)));
constexpr int BM = 256, BK = 64, HALF = 128, HTB = HALF * BK * 2  , STAGE_BYTES = 8 * HTB, NXCD = 8, WGM = 8;

__host__ __device__ __forceinline__ int lds_byte(int r, int c) { const int st = (r >> 4) * 2 + (c >> 5), rr = r & 15, cc = c & 31, ob = rr * 64 + cc * 2; return st * 1024 + (ob ^ (((ob >> 9) & 1) << 5)); }
__host__ __device__ __forceinline__ void stage_rc(int b, int& R, int& C) { const int st = b / 1024, sb = b % 1024, swz = sb ^ (((sb >> 9) & 1) << 5); R = (st >> 1) * 16 + swz / 64; C = (st & 1) * 32 + (swz % 64) / 2; }
__host__ __device__ __forceinline__ int perm32(int rho) { const int n = rho >> 4, i = rho & 15; return 8 * (i >> 2) + 4 * n + (i & 3); }

struct Unit { int pm, pn; };
struct Gemm { const bf16_t* A; const bf16_t* Bt; int M, N, K; };

struct StaticOrder {
    int nM, nN, nwg, G, c;
    __host__ __device__ void init(int M, int N, int G_, int c_) { nM = M / BM; nN = N / BM; nwg = nM * nN; G = G_; c = c_; }
    __host__ __device__ bool next(int i, Unit& u) const {
        const long L = (long)i * G + c; if (L >= nwg) return false;
        int wgid = (int)L; { const int q = nwg / NXCD, r = nwg % NXCD, xcd = wgid % NXCD, off = wgid / NXCD; wgid = (xcd < r ? xcd * (q + 1) : r * (q + 1) + (xcd - r) * q) + off; }
        const int nig = WGM * nN, gid = wgid / nig, fm = gid * WGM, gsz = (nM - fm) < WGM ? (nM - fm) : WGM;
        u.pm = fm + ((wgid % nig) % gsz); u.pn = (wgid % nig) / gsz; return true;
    }
    __device__ __forceinline__ void a_ready(const Unit&) const {}
    __device__ __forceinline__ void done(const Unit&) const {}
};

__device__ __forceinline__ unsigned cvt_pk_bf16(float lo, float hi) { unsigned r; asm volatile("v_cvt_pk_bf16_f32 %0, %1, %2" : "=v"(r) : "v"(lo), "v"(hi)); return r; }
typedef float f32x2 __attribute__((ext_vector_type(2)));
__device__ __forceinline__ f32x2 gelu_pk(f32x2 v) {
    const f32x2 av = __builtin_elementwise_abs(v), d = av * 0.2316418882f + 1.0f;
    f32x2 t; t.x = __builtin_amdgcn_rcpf(d.x); t.y = __builtin_amdgcn_rcpf(d.y);
    f32x2 q = t * 0.5307027145f + (-0.7265760135f); q = q * t + 0.7107068705f; q = q * t + (-0.142248368f); q = q * t + 0.127414796f; q = q * t;
    const f32x2 s = (v * v) * (-0.72134752044f);
    f32x2 e; e.x = __builtin_amdgcn_exp2f(s.x); e.y = __builtin_amdgcn_exp2f(s.y);
    const f32x2 m = v * (q * e), r = v - m;
    f32x2 o; o.x = v.x < 0.f ? m.x : r.x; o.y = v.y < 0.f ? m.y : r.y; return o;
}

template <int ACT  > struct EpiBf16 {
    static constexpr bool PERM = true, AFTER_DRAIN = false; static_assert(ACT == 0 || ACT == 1, "EpiBf16: ACT is 0 (none) or 1 (gelu_pk)");
    bf16_t* O; int ldc; const float* bias; int split_cols; size_t split_stride; float scale0;
    __device__ __forceinline__ void operator()(const f32x4 (&acc)[2][2][4][2], const Unit& u, int wr, int wc, int fr, int fq) const {
        const int row0 = u.pm * BM + wr * 64 + fr; int colt = u.pn * BM; bf16_t* base = O;
        float sc = 1.f; if (split_cols) { const int t = colt / split_cols; base += (size_t)t * split_stride; colt -= t * split_cols; if (t == 0) sc = scale0; }
        const int col0 = colt + wc * 32 + 8 * fq, bcol0 = u.pn * BM + wc * 32 + 8 * fq;
        f32x4 bv[2][2];
#pragma unroll
        for (int bj = 0; bj < 2; ++bj)
#pragma unroll
            for (int n = 0; n < 2; ++n) bv[bj][n] = bias ? *(const f32x4*)(bias + bcol0 + bj * HALF + 4 * n) : (f32x4){0.f, 0.f, 0.f, 0.f};
#pragma unroll
        for (int ai = 0; ai < 2; ++ai)
#pragma unroll
            for (int m = 0; m < 4; ++m) { bf16_t* rowp = base + (size_t)(row0 + ai * HALF + m * 16) * ldc + col0;
#pragma unroll
                for (int bj = 0; bj < 2; ++bj) { f32x4 v0 = acc[ai][bj][m][0] + bv[bj][0], v1 = acc[ai][bj][m][1] + bv[bj][1];
                    if (ACT == 1) { f32x2 a = gelu_pk((f32x2){v0[0], v0[1]}), b = gelu_pk((f32x2){v0[2], v0[3]}), c = gelu_pk((f32x2){v1[0], v1[1]}), d = gelu_pk((f32x2){v1[2], v1[3]});
                        v0 = (f32x4){a.x, a.y, b.x, b.y}; v1 = (f32x4){c.x, c.y, d.x, d.y}; }
                    v0 = v0 * sc; v1 = v1 * sc; u32x4 w; w.x = cvt_pk_bf16(v0[0], v0[1]); w.y = cvt_pk_bf16(v0[2], v0[3]); w.z = cvt_pk_bf16(v1[0], v1[1]); w.w = cvt_pk_bf16(v1[2], v1[3]);
                    *(u32x4*)(rowp + bj * HALF) = w; } }
    }
};
template <class Epi, class Sched, bool ALIGN_EPI = false, bool SP2 = false>
__device__ __forceinline__ void gemm_phase(PG8_LAS unsigned char* lds, const Gemm g, const Sched& S, const Epi& E) {
    const int tid = threadIdx.x, wid = __builtin_amdgcn_readfirstlane(tid >> 6), lane = tid & 63, wr = wid >> 2, wc = wid & 3, fr = lane & 15, fq = lane >> 4;
    const int K = g.K, nt = K / BK;
    unsigned voffA[2], voffB[2];
#pragma unroll
    for (int i = 0; i < 2; ++i) { int R, C; stage_rc(tid * 16 + i * 8192, R, C); const int Rb = Epi::PERM ? ((R & ~31) + perm32(R & 31)) : R;
        voffA[i] = (unsigned)(R * K + C) * 2u; voffB[i] = (unsigned)(Rb * K + C) * 2u; }
    const size_t kstep = (size_t)(BK * 2);
    const size_t hstep = (size_t)HALF * K * 2;
    const size_t tstep = 2 * hstep;
    const unsigned ldsw = (unsigned)wid * 1024u;
    const int aoff = lds_byte(wr * 64 + fr, fq * 8), boff = lds_byte(wc * 32 + fr, fq * 8);
#define PG8_SA(b, h) (((b) * 2 + (h)) * HTB)
#define PG8_SB(b, h) ((4 + (b) * 2 + (h)) * HTB)
#define PG8_STAGE(bufoff, gbase, voff) do { _Pragma("unroll") for (int _i = 0; _i < 2; ++_i) \
        __builtin_amdgcn_global_load_lds((const unsigned*)((const char*)(gbase) + (voff)[_i]), (PG8_LAS unsigned*)(lds + (bufoff) + ldsw + _i * 8192), 16, 0, 0); } while (0)
#define PG8_LDA(dst, b, h) do { _Pragma("unroll") for (int m = 0; m < 4; ++m) _Pragma("unroll") for (int k = 0; k < 2; ++k) dst[m][k] = *(const PG8_LAS bf16x8*)(lds + PG8_SA(b, h) + aoff + m * 2048 + k * 1024); } while (0)
#define PG8_LDB(dst, b, h) do { _Pragma("unroll") for (int n = 0; n < 2; ++n) _Pragma("unroll") for (int k = 0; k < 2; ++k) dst[n][k] = *(const PG8_LAS bf16x8*)(lds + PG8_SB(b, h) + boff + n * 2048 + k * 1024); } while (0)
#define PG8_MMA(ai, bj, At, Bt) do { __builtin_amdgcn_s_setprio(1); _Pragma("unroll") for (int m = 0; m < 4; ++m) _Pragma("unroll") for (int n = 0; n < 2; ++n) _Pragma("unroll") for (int k = 0; k < 2; ++k) \
        acc[ai][bj][m][n] = __builtin_amdgcn_mfma_f32_16x16x32_bf16(Bt[n][k], At[m][k], acc[ai][bj][m][n], 0, 0, 0); __builtin_amdgcn_s_setprio(0); } while (0)
#define PG8_WAIT_V(n) asm volatile("s_waitcnt vmcnt(" #n ")" ::: "memory")
#define PG8_WAIT_L(n) asm volatile("s_waitcnt lgkmcnt(" #n ")" ::: "memory")
#define PG8_BAR __builtin_amdgcn_s_barrier()
#define PG8_SCHED __builtin_amdgcn_sched_barrier(0)
    Unit cur, nxt; int ui = 0;
    if (!S.next(0, cur)) return;
    f32x4 acc[2][2][4][2];
#pragma unroll
    for (int a = 0; a < 2; ++a)
#pragma unroll
        for (int b = 0; b < 2; ++b)
#pragma unroll
            for (int m = 0; m < 4; ++m)
#pragma unroll
                for (int n = 0; n < 2; ++n) acc[a][b][m][n] = (f32x4){0.f, 0.f, 0.f, 0.f};
    bf16x8 At[4][2], B0[2][2], B1[2][2];
    const char* cA = (const char*)g.A + (size_t)cur.pm * tstep; const char* cB = (const char*)g.Bt + (size_t)cur.pn * tstep;
    S.a_ready(cur);
    if constexpr (SP2) {
        PG8_STAGE(PG8_SB(0, 0), cB, voffB); PG8_STAGE(PG8_SB(0, 1), cB + hstep, voffB); PG8_STAGE(PG8_SA(0, 0), cA, voffA); PG8_STAGE(PG8_SA(0, 1), cA + hstep, voffA);
        if (wr == 1) PG8_BAR;
        PG8_WAIT_V(2); PG8_BAR;
        PG8_STAGE(PG8_SB(1, 0), cB + kstep, voffB); PG8_STAGE(PG8_SA(1, 0), cA + kstep, voffA); PG8_STAGE(PG8_SB(1, 1), cB + hstep + kstep, voffB);
        PG8_WAIT_V(6); PG8_BAR;
    } else {
        PG8_STAGE(PG8_SB(0, 0), cB, voffB); PG8_STAGE(PG8_SA(0, 0), cA, voffA); PG8_STAGE(PG8_SB(0, 1), cB + hstep, voffB); PG8_STAGE(PG8_SA(0, 1), cA + hstep, voffA);
        if (wr == 1) PG8_BAR;
        PG8_WAIT_V(4); PG8_BAR;
        PG8_STAGE(PG8_SB(1, 0), cB + kstep, voffB); PG8_STAGE(PG8_SA(1, 0), cA + kstep, voffA); PG8_STAGE(PG8_SB(1, 1), cB + hstep + kstep, voffB);
        PG8_WAIT_V(6); PG8_BAR;
    }
    for (;;) {
        const bool has_next = S.next(ui + 1, nxt);
        const char* nA = has_next ? (const char*)g.A + (size_t)nxt.pm * tstep : cA; const char* nB = has_next ? (const char*)g.Bt + (size_t)nxt.pn * tstep : cB;
        for (int t = 0; t < nt; t += 2) {
            const bool last = (t == nt - 2);
            const char* a1 = cA + (size_t)(t + 1) * kstep;
            const char* a2 = last ? nA : cA + (size_t)(t + 2) * kstep; const char* b2 = last ? nB : cB + (size_t)(t + 2) * kstep;
            const char* a3 = a2 + kstep; const char* b3 = b2 + kstep;
            if (last && has_next) S.a_ready(nxt);
            if constexpr (SP2) {
            PG8_LDB(B0, 0, 0); PG8_LDB(B1, 0, 1); PG8_SCHED; PG8_LDA(At, 0, 0); PG8_STAGE(PG8_SA(1, 1), a1 + hstep, voffA);
            PG8_WAIT_V(8); PG8_WAIT_L(0); PG8_BAR; PG8_MMA(0, 0, At, B0); PG8_MMA(0, 1, At, B1); PG8_BAR; PG8_SCHED;
            PG8_LDA(At, 0, 1); PG8_STAGE(PG8_SB(0, 0), b2, voffB); PG8_STAGE(PG8_SB(0, 1), b2 + hstep, voffB); PG8_STAGE(PG8_SA(0, 0), a2, voffA);
            PG8_WAIT_V(8); PG8_WAIT_L(0); PG8_BAR; PG8_MMA(1, 0, At, B0); PG8_MMA(1, 1, At, B1); PG8_BAR; PG8_SCHED;
            PG8_LDB(B0, 1, 0); PG8_LDB(B1, 1, 1); PG8_SCHED; PG8_LDA(At, 1, 0); PG8_STAGE(PG8_SA(0, 1), a2 + hstep, voffA);
            PG8_WAIT_V(8); PG8_WAIT_L(0); PG8_BAR; PG8_MMA(0, 0, At, B0); PG8_MMA(0, 1, At, B1); PG8_BAR; PG8_SCHED;
            PG8_LDA(At, 1, 1); PG8_STAGE(PG8_SB(1, 0), b3, voffB); PG8_STAGE(PG8_SB(1, 1), b3 + hstep, voffB); PG8_STAGE(PG8_SA(1, 0), a3, voffA);
            PG8_WAIT_V(8); PG8_WAIT_L(0); PG8_BAR; PG8_MMA(1, 0, At, B0); PG8_MMA(1, 1, At, B1); PG8_BAR; PG8_SCHED;
            } else {
            PG8_LDB(B0, 0, 0); PG8_SCHED; PG8_LDA(At, 0, 0); PG8_STAGE(PG8_SA(1, 1), a1 + hstep, voffA);
            PG8_WAIT_L(8); PG8_BAR; PG8_WAIT_L(0); PG8_MMA(0, 0, At, B0); PG8_BAR; PG8_SCHED;
            PG8_LDB(B1, 0, 1); PG8_STAGE(PG8_SB(0, 0), b2, voffB);
            PG8_BAR; PG8_WAIT_L(0); PG8_MMA(0, 1, At, B1); PG8_BAR;
            PG8_LDA(At, 0, 1); PG8_STAGE(PG8_SA(0, 0), a2, voffA);
            PG8_BAR; PG8_WAIT_L(0); PG8_MMA(1, 0, At, B0); PG8_BAR; PG8_SCHED;
            PG8_STAGE(PG8_SB(0, 1), b2 + hstep, voffB);
            PG8_WAIT_V(6); PG8_BAR; PG8_MMA(1, 1, At, B1); PG8_BAR;
            PG8_LDB(B0, 1, 0); PG8_SCHED; PG8_LDA(At, 1, 0); PG8_STAGE(PG8_SA(0, 1), a2 + hstep, voffA);
            PG8_WAIT_L(8); PG8_BAR; PG8_WAIT_L(0); PG8_MMA(0, 0, At, B0); PG8_BAR; PG8_SCHED;
            PG8_LDB(B1, 1, 1); PG8_STAGE(PG8_SB(1, 0), b3, voffB);
            PG8_BAR; PG8_WAIT_L(0); PG8_MMA(0, 1, At, B1); PG8_BAR;
            PG8_LDA(At, 1, 1); PG8_STAGE(PG8_SA(1, 0), a3, voffA);
            PG8_BAR; PG8_WAIT_L(0); PG8_MMA(1, 0, At, B0); PG8_BAR; PG8_SCHED;
            PG8_STAGE(PG8_SB(1, 1), b3 + hstep, voffB);
            PG8_WAIT_V(6); PG8_BAR; PG8_MMA(1, 1, At, B1); PG8_BAR;
            }
        }
        if constexpr (ALIGN_EPI) { if (wr == 0) PG8_BAR; }
        if constexpr (!Epi::AFTER_DRAIN) { E(acc, cur, wr, wc, fr, fq); S.done(cur); }
        if (!has_next) break;
#pragma unroll
        for (int a = 0; a < 2; ++a)
#pragma unroll
            for (int b = 0; b < 2; ++b)
#pragma unroll
                for (int m = 0; m < 4; ++m)
#pragma unroll
                    for (int n = 0; n < 2; ++n) acc[a][b][m][n] = (f32x4){0.f, 0.f, 0.f, 0.f};
        cur = nxt; cA = nA; cB = nB; ++ui;
        if constexpr (ALIGN_EPI) { if (wr == 1) PG8_BAR; }
    }
    PG8_WAIT_V(0);
    if constexpr (!ALIGN_EPI) { if (wr == 0) PG8_BAR; }
    PG8_BAR;
    if constexpr (Epi::AFTER_DRAIN) { E.fused(acc, cur, wr, wc, fr, fq, lds, wid, lane); S.done(cur); }
#undef PG8_SA
#undef PG8_SB
#undef PG8_STAGE
#undef PG8_LDA
#undef PG8_LDB
#undef PG8_MMA
#undef PG8_WAIT_V
#undef PG8_WAIT_L
#undef PG8_BAR
#undef PG8_SCHED
}
}
namespace pg8 {
typedef float f32x2e __attribute__((ext_vector_type(2))); typedef __bf16 bf16x2e __attribute__((ext_vector_type(2)));
__device__ __forceinline__ unsigned pkbf(float lo, float hi) { f32x2e v = {lo, hi}; bf16x2e b = __builtin_convertvector(v, bf16x2e); return __builtin_bit_cast(unsigned, b); }
struct EpiVt {
    static constexpr bool PERM = true, AFTER_DRAIN = false;
    bf16_t* O; int ldc; const float* biasrow;
    __device__ __forceinline__ void operator()(const f32x4 (&acc)[2][2][4][2], const Unit& u, int wr, int wc, int fr, int fq) const {
        const int row0 = u.pm * BM + wr * 64 + fr, col0 = u.pn * BM + wc * 32 + 8 * fq;
#pragma unroll
        for (int ai = 0; ai < 2; ++ai)
#pragma unroll
            for (int m = 0; m < 4; ++m) { const int r = row0 + ai * HALF + m * 16; const float b = biasrow[r]; bf16_t* rowp = O + (size_t)r * ldc + col0;
#pragma unroll
                for (int bj = 0; bj < 2; ++bj) { const f32x4 v0 = acc[ai][bj][m][0] + b, v1 = acc[ai][bj][m][1] + b;
                    u32x4 w; w.x = pkbf(v0[0], v0[1]); w.y = pkbf(v0[2], v0[3]); w.z = pkbf(v1[0], v1[1]); w.w = pkbf(v1[2], v1[3]);
                    *(u32x4*)(rowp + bj * HALF) = w; } }
    }
};
struct EpiRes {
    static constexpr bool PERM = false, AFTER_DRAIN = false;
    const float* X; float* Y; const float* gate; float alpha;
    __device__ __forceinline__ void operator()(const f32x4 (&acc)[2][2][4][2], const Unit& u, int wr, int wc, int fr, int fq) const {
        const int col0 = u.pn * BM + wc * 32 + 4 * fq; const int b = (u.pm * BM) >> 13;
        f32x4 gv[2][2];
#pragma unroll
        for (int bj = 0; bj < 2; ++bj)
#pragma unroll
            for (int n = 0; n < 2; ++n) gv[bj][n] = *(const f32x4*)(gate + b * 6144 + col0 + bj * HALF + n * 16) + 1.0f;
#pragma unroll
        for (int ai = 0; ai < 2; ++ai)
#pragma unroll
            for (int m = 0; m < 4; ++m) { const int r = u.pm * BM + ai * HALF + wr * 64 + m * 16 + fr; const size_t off = (size_t)r * 1024 + col0;
#pragma unroll
                for (int bj = 0; bj < 2; ++bj)
#pragma unroll
                    for (int n = 0; n < 2; ++n) { const f32x4 xv = *(const f32x4*)(X + off + bj * HALF + n * 16);
                        *(f32x4*)(Y + off + bj * HALF + n * 16) = xv * alpha + gv[bj][n] * acc[ai][bj][m][n]; } }
    }
};
struct EpiGU {
    static constexpr bool PERM = true, AFTER_DRAIN = false;
    bf16_t* H; int ldc;
    __device__ __forceinline__ void operator()(const f32x4 (&acc)[2][2][4][2], const Unit& u, int wr, int wc, int fr, int fq) const {
        const int row0 = u.pm * BM + wr * 64 + fr, col0 = u.pn * HALF + wc * 32 + 8 * fq;
#pragma unroll
        for (int ai = 0; ai < 2; ++ai)
#pragma unroll
            for (int m = 0; m < 4; ++m) { bf16_t* rowp = H + (size_t)(row0 + ai * HALF + m * 16) * ldc + col0;
                float h[8];
#pragma unroll
                for (int n = 0; n < 2; ++n)
#pragma unroll
                    for (int e = 0; e < 4; ++e) { const float g = acc[ai][0][m][n][e], up = acc[ai][1][m][n][e];
                        const float sg = g * __builtin_amdgcn_rcpf(1.0f + __builtin_amdgcn_exp2f(-1.4426950408889634f * g)); h[4 * n + e] = sg * up; }
                u32x4 w; w.x = pkbf(h[0], h[1]); w.y = pkbf(h[2], h[3]); w.z = pkbf(h[4], h[5]); w.w = pkbf(h[6], h[7]);
                *(u32x4*)rowp = w; }
    }
};
}
#ifndef MK_COOP
#define MK_COOP 1
#endif
typedef unsigned short bf16;
typedef float f32x4 __attribute__((ext_vector_type(4)));
typedef float f32x16 __attribute__((ext_vector_type(16)));
typedef short bf16x8 __attribute__((ext_vector_type(8)));
typedef short s16x4 __attribute__((ext_vector_type(4)));
typedef unsigned v4u __attribute__((ext_vector_type(4)));
typedef unsigned v2u __attribute__((ext_vector_type(2)));
#define LAS __attribute__((address_space(3)))
constexpr int SEQ = 8192, M = 16384, D = 1024, NQK = 1792, NVT = 768, DFF = 2816, NGU = 5632, NMOD = 6144, DIN = 2304;
constexpr float LOG2E = 1.4426950408889634f, SC2 = 0.125f * LOG2E;
constexpr float DN_ALPHA = 1.189207115002721f;
constexpr float SB_STOP = 151.0f;
constexpr size_t MiB = 1u << 20;
constexpr size_t WS_MOD = 0, WS_BQK = 64 * 1024, WS_BVT = 80 * 1024;
constexpr size_t WS_WQK = 1 * MiB, WS_WV = 5 * MiB, WS_WOUT = 7 * MiB, WS_WGU = 9 * MiB, WS_WDOWN = 20 * MiB;
constexpr size_t WS_XN = 26 * MiB, WS_PROJ = 58 * MiB, WS_VT = 114 * MiB, WS_MIXED = 138 * MiB, WS_Y = 170 * MiB, WS_HMID = 58 * MiB, WS_END = 234 * MiB;
static_assert(WS_HMID + (size_t)M * DFF * 2 <= WS_Y, "hmid overlays proj/vt/mixed only");
constexpr int LDS_BYTES = 147456;
constexpr int NWAVES = 8;

__device__ __forceinline__ unsigned pk2(float lo, float hi) { return pg8::pkbf(lo, hi); }
__device__ __forceinline__ float wave_sum(float v) {
#pragma unroll
    for (int o = 1; o < 64; o <<= 1) v += __shfl_xor(v, o);
    return v;
}

__device__ __forceinline__ void tr_item(const float* __restrict__ W, int ldw, int k0, int c0, bf16* WT, int ldt, int drow0, float* scr, int lane) {
#pragma unroll 8
    for (int i = 0; i < 32; ++i) { const int kk = 2 * i + (lane >> 5); scr[kk * 33 + (lane & 31)] = W[(size_t)(k0 + kk) * ldw + c0 + (lane & 31)]; }
    asm volatile("s_waitcnt lgkmcnt(0)" ::: "memory");
    const int c = lane & 7;
#pragma unroll
    for (int j = 0; j < 4; ++j) { const int n = (lane >> 3) + 8 * j; const float* s = scr + (8 * c) * 33 + n;
        v4u o; o.x = pk2(s[0 * 33], s[1 * 33]); o.y = pk2(s[2 * 33], s[3 * 33]); o.z = pk2(s[4 * 33], s[5 * 33]); o.w = pk2(s[6 * 33], s[7 * 33]);
        *(v4u*)(WT + (size_t)(drow0 + n) * ldt + k0 + 8 * c) = o; }
    asm volatile("s_waitcnt lgkmcnt(0)" ::: "memory");
}

struct Ptrs {
    const float *x, *c, *w_ada, *b_ada, *w_in, *b_in, *sinks, *gn_sb, *gn_swa, *w_out, *ln1_g, *ln1_b, *w_gu, *w_down, *ln2_g, *ln2_b;
    float* out; unsigned char* ws;
};

__device__ __forceinline__ void phase_weights(const Ptrs& P, unsigned char* lds, int tid, int lane, int wave) {
    unsigned char* ws = P.ws;
    float* MOD = (float*)(ws + WS_MOD);
    for (int j = blockIdx.x; j < NMOD / 64; j += gridDim.x) {
        float* red = (float*)lds;
        const int col = 64 * j + lane; float a0 = 0.f, a1 = 0.f;
#pragma unroll 8
        for (int k = 128 * wave; k < 128 * wave + 128; ++k) {
            const float wv = P.w_ada[(size_t)k * NMOD + col]; const float c0 = P.c[k], c1 = P.c[D + k];
            a0 += (c0 / (1.0f + __expf(-c0))) * wv; a1 += (c1 / (1.0f + __expf(-c1))) * wv; }
        red[(wave * 2 + 0) * 64 + lane] = a0; red[(wave * 2 + 1) * 64 + lane] = a1;
        __syncthreads();
        if (tid < 128) { const int b = tid >> 6, l = tid & 63; float s = 0.f;
#pragma unroll
            for (int w = 0; w < 8; ++w) s += red[(w * 2 + b) * 64 + l];
            MOD[b * NMOD + 64 * j + l] = s + P.b_ada[64 * j + l]; }
        __syncthreads();
    }
    const int gt = blockIdx.x * 512 + tid, NGT = gridDim.x * 512;
    float* bqk = (float*)(ws + WS_BQK); float* bvt = (float*)(ws + WS_BVT);
    for (int i = gt; i < NQK; i += NGT) bqk[i] = i < 1024 ? P.b_in[i] : (i < 1664 ? P.b_in[i + 512] : 0.f);
    for (int i = gt; i < NVT; i += NGT) bvt[i] = i < 512 ? P.b_in[1024 + i] : (i < 640 ? P.b_in[2176 + i - 512] : 0.f);
    { v4u z = {0u, 0u, 0u, 0u}; v4u* p0 = (v4u*)((bf16*)(ws + WS_WQK) + (size_t)1664 * D); v4u* p1 = (v4u*)((bf16*)(ws + WS_WV) + (size_t)640 * D);
      for (int i = gt; i < 128 * D / 8; i += NGT) { p0[i] = z; p1[i] = z; } }
    float* scr = (float*)(lds + 4096 + wave * 8704);
    const int gw = blockIdx.x * NWAVES + wave, NGW = gridDim.x * NWAVES;
    constexpr int I_IN = 16 * 72, I_OUT = 16 * 32, I_GU = 16 * 176, I_DN = 44 * 32, NIT = I_IN + I_OUT + I_GU + I_DN;
    for (int it = gw; it < NIT; it += NGW) {
        int r = it;
        if (r < I_IN) { const int kb = r / 72, c0 = 32 * (r % 72); bf16* dst; int drow;
            if (c0 < 1024) { dst = (bf16*)(ws + WS_WQK); drow = c0; }
            else if (c0 < 1536) { dst = (bf16*)(ws + WS_WV); drow = c0 - 1024; }
            else if (c0 < 2176) { dst = (bf16*)(ws + WS_WQK); drow = c0 - 512; }
            else { dst = (bf16*)(ws + WS_WV); drow = c0 - 2176 + 512; }
            tr_item(P.w_in, DIN, 64 * kb, c0, dst, D, drow, scr, lane); continue; }
        r -= I_IN;
        if (r < I_OUT) { const int kb = r / 32, c0 = 32 * (r % 32); tr_item(P.w_out, D, 64 * kb, c0, (bf16*)(ws + WS_WOUT), D, c0, scr, lane); continue; }
        r -= I_OUT;
        if (r < I_GU) { const int kb = r / 176, c0 = 32 * (r % 176); const int cc = c0 < DFF ? c0 : c0 - DFF; const int drow = 256 * (cc / 128) + (cc % 128) + (c0 < DFF ? 0 : 128);
            tr_item(P.w_gu, NGU, 64 * kb, c0, (bf16*)(ws + WS_WGU), D, drow, scr, lane); continue; }
        r -= I_GU;
        { const int kb = r / 32, c0 = 32 * (r % 32); tr_item(P.w_down, D, 64 * kb, c0, (bf16*)(ws + WS_WDOWN), DFF, c0, scr, lane); }
    }
}

__device__ __forceinline__ void phase_mod_rows(const Ptrs& P, int lane, int wave) {
    const float* MOD = (const float*)(P.ws + WS_MOD); bf16* XN = (bf16*)(P.ws + WS_XN);
    const int gw = blockIdx.x * NWAVES + wave, NGW = gridDim.x * NWAVES;
    for (int m = gw; m < M; m += NGW) { const int b = m >> 13; const f32x4* xr = (const f32x4*)(P.x + (size_t)m * D) + lane;
        const f32x4* sh = (const f32x4*)(MOD + b * NMOD) + lane; const f32x4* sc = (const f32x4*)(MOD + b * NMOD + D) + lane;
        unsigned long long* o8 = (unsigned long long*)(XN + (size_t)m * D) + lane;
#pragma unroll
        for (int j = 0; j < 4; ++j) { const f32x4 v = xr[64 * j] * (sc[64 * j] + 1.0f) + sh[64 * j];
            o8[64 * j] = (unsigned long long)pk2(v.x, v.y) | ((unsigned long long)pk2(v.z, v.w) << 32); } }
}
template <bool WITH_XN> __device__ __forceinline__ void phase_ln_rows(const Ptrs& P, const float* Y, const float* g, const float* bta, float* X1, int lane, int wave) {
    const float* MOD = (const float*)(P.ws + WS_MOD); bf16* XN = (bf16*)(P.ws + WS_XN);
    const int gw = blockIdx.x * NWAVES + wave, NGW = gridDim.x * NWAVES;
    for (int m = gw; m < M; m += NGW) { const int b = m >> 13; const f32x4* yr = (const f32x4*)(Y + (size_t)m * D) + lane;
        f32x4 v[4]; float s = 0.f;
#pragma unroll
        for (int j = 0; j < 4; ++j) { v[j] = yr[64 * j]; s += (v[j].x + v[j].y) + (v[j].z + v[j].w); }
        const float mean = wave_sum(s) * (1.f / D); float s2 = 0.f;
#pragma unroll
        for (int j = 0; j < 4; ++j) { v[j] = v[j] - mean; s2 += (v[j].x * v[j].x + v[j].y * v[j].y) + (v[j].z * v[j].z + v[j].w * v[j].w); }
        const float rstd = 1.f / sqrtf(wave_sum(s2) * (1.f / D) + 1e-5f);
        f32x4* xo = (f32x4*)(X1 + (size_t)m * D) + lane;
        const f32x4* gg = (const f32x4*)g + lane; const f32x4* bb = (const f32x4*)bta + lane;
        const f32x4* sh = (const f32x4*)(MOD + b * NMOD + 3 * D) + lane; const f32x4* sc = (const f32x4*)(MOD + b * NMOD + 4 * D) + lane;
        unsigned long long* o8 = (unsigned long long*)(XN + (size_t)m * D) + lane;
#pragma unroll
        for (int j = 0; j < 4; ++j) { const f32x4 x1 = v[j] * rstd * gg[64 * j] + bb[64 * j]; xo[64 * j] = x1;
            if (WITH_XN) { const f32x4 h = x1 * (sc[64 * j] + 1.0f) + sh[64 * j]; o8[64 * j] = (unsigned long long)pk2(h.x, h.y) | ((unsigned long long)pk2(h.z, h.w) << 32); } } }
}

struct KVf { bf16x8 k[4]; bf16x8 v[2][2]; };
__device__ __forceinline__ void load_kv(KVf& f, const bf16* __restrict__ Kp, const bf16* __restrict__ Vp, size_t tok) {
#pragma unroll
    for (int d0 = 0; d0 < 4; ++d0) f.k[d0] = *(const bf16x8*)(Kp + tok * NQK + 16 * d0);
#pragma unroll
    for (int dt = 0; dt < 2; ++dt)
#pragma unroll
        for (int ks = 0; ks < 2; ++ks) { const bf16* p = Vp + (size_t)dt * 32 * M + tok + 16 * ks; const s16x4 lo = *(const s16x4*)p, hi4 = *(const s16x4*)(p + 8);
            f.v[dt][ks] = (bf16x8){lo[0], lo[1], lo[2], lo[3], hi4[0], hi4[1], hi4[2], hi4[3]}; }
}
__device__ __forceinline__ f32x16 qk_tile(const KVf& f, const bf16x8 (&qf)[4]) {
    f32x16 s = {};
#pragma unroll
    for (int d0 = 0; d0 < 4; ++d0) s = __builtin_amdgcn_mfma_f32_32x32x16_bf16(f.k[d0], qf[d0], s, 0, 0, 0);
    return s;
}
__device__ __forceinline__ void pv_tile(f32x16 (&o)[2], const KVf& f, const float (&w)[16]) {
    v4u p0, p1; p0.x = pk2(w[0], w[1]); p0.y = pk2(w[2], w[3]); p0.z = pk2(w[4], w[5]); p0.w = pk2(w[6], w[7]);
    p1.x = pk2(w[8], w[9]); p1.y = pk2(w[10], w[11]); p1.z = pk2(w[12], w[13]); p1.w = pk2(w[14], w[15]);
    const bf16x8 b0 = __builtin_bit_cast(bf16x8, p0), b1 = __builtin_bit_cast(bf16x8, p1);
#pragma unroll
    for (int dt = 0; dt < 2; ++dt) { o[dt] = __builtin_amdgcn_mfma_f32_32x32x16_bf16(f.v[dt][0], b0, o[dt], 0, 0, 0); o[dt] = __builtin_amdgcn_mfma_f32_32x32x16_bf16(f.v[dt][1], b1, o[dt], 0, 0, 0); }
}
template <bool DIAG> __device__ __forceinline__ void sb_step(const KVf& f, const bf16x8 (&qf)[4], f32x16 (&o)[2], float& c_run, int r32, int hi) {
    const f32x16 s = qk_tile(f, qf);
    float z[16], r[16];
#pragma unroll
    for (int i = 0; i < 16; ++i) { z[i] = s[i] * SC2; const float e = __builtin_amdgcn_exp2f(-__builtin_fabsf(z[i]));
        float sp = __builtin_fmaxf(z[i], 0.f) + __builtin_amdgcn_logf(1.0f + e);
        if (DIAG) { const int kk = 8 * (i >> 2) + 4 * hi + (i & 3); if (!(kk < r32)) sp = 0.f; }
        r[i] = sp; }
    float G[4], Gp[4];
#pragma unroll
    for (int g = 0; g < 4; ++g) { r[4 * g + 2] += r[4 * g + 3]; r[4 * g + 1] += r[4 * g + 2]; r[4 * g] += r[4 * g + 1]; G[g] = r[4 * g]; }
#pragma unroll
    for (int g = 0; g < 4; ++g) Gp[g] = __shfl_xor(G[g], 32);
    float off[4]; float above = c_run;
#pragma unroll
    for (int g = 3; g >= 0; --g) { off[g] = above + (hi == 0 ? Gp[g] : 0.f); above += (G[g] + Gp[g]); }
    c_run = above;
    float w[16];
#pragma unroll
    for (int i = 0; i < 16; ++i) { float wv = __builtin_amdgcn_exp2f(z[i] - (r[i] + off[i >> 2]));
        if (DIAG) { const int kk = 8 * (i >> 2) + 4 * hi + (i & 3); if (!(kk < r32)) wv = 0.f; }
        w[i] = wv; }
    pv_tile(o, f, w);
}
__device__ __forceinline__ void swa_step(const KVf& f, const bf16x8 (&qf)[4], f32x16 (&o)[2], float& m_run, float& l_run, float slope2, int dist0  , int hi) {
    const f32x16 s = qk_tile(f, qf);
    float sc[16]; float mx = -1e30f;
#pragma unroll
    for (int i = 0; i < 16; ++i) { const int dist = dist0 - (8 * (i >> 2) + 4 * hi + (i & 3)); const bool valid = (unsigned)dist < 128u;
        sc[i] = valid ? s[i] * SC2 - slope2 * (float)dist : -1e30f; mx = __builtin_fmaxf(mx, sc[i]); }
    mx = __builtin_fmaxf(mx, __shfl_xor(mx, 32));
    const float m_new = __builtin_fmaxf(m_run, mx); const float al = __builtin_amdgcn_exp2f(m_run - m_new); m_run = m_new;
    float w[16]; float ls = 0.f;
#pragma unroll
    for (int i = 0; i < 16; ++i) { w[i] = __builtin_amdgcn_exp2f(sc[i] - m_new); ls += w[i]; }
    l_run = l_run * al + ls;
#pragma unroll
    for (int dt = 0; dt < 2; ++dt)
#pragma unroll
        for (int i = 0; i < 16; ++i) o[dt][i] *= al;
    pv_tile(o, f, w);
}
constexpr int STG_PITCH = 516;
__device__ __forceinline__ void finish_unit(const f32x16 (&o)[2], float scale, float* stage, int wave, int lane, size_t row0, const float* __restrict__ gn, bf16* MIXED, int goff) {
    const int r32 = lane & 31, hi = lane >> 5;
#pragma unroll
    for (int dt = 0; dt < 2; ++dt)
#pragma unroll
        for (int g = 0; g < 4; ++g) { f32x4 v = {o[dt][4 * g] * scale, o[dt][4 * g + 1] * scale, o[dt][4 * g + 2] * scale, o[dt][4 * g + 3] * scale};
            *(f32x4*)(stage + r32 * STG_PITCH + wave * 64 + 32 * dt + 8 * g + 4 * hi) = v; }
    __syncthreads();
    const f32x4 g0 = *(const f32x4*)(gn + 8 * lane), g1 = *(const f32x4*)(gn + 8 * lane + 4);
#pragma unroll
    for (int qq = 0; qq < 4; ++qq) { const int q = wave * 4 + qq; const f32x4 a = *(const f32x4*)(stage + q * STG_PITCH + 8 * lane), b = *(const f32x4*)(stage + q * STG_PITCH + 8 * lane + 4);
        float ss = (a.x * a.x + a.y * a.y) + (a.z * a.z + a.w * a.w) + (b.x * b.x + b.y * b.y) + (b.z * b.z + b.w * b.w);
        const float rs = 1.0f / sqrtf(wave_sum(ss) * (1.0f / 512.0f) + 1e-6f);
        const f32x4 ya = a * rs * g0, yb = b * rs * g1; v4u w; w.x = pk2(ya.x, ya.y); w.y = pk2(ya.z, ya.w); w.z = pk2(yb.x, yb.y); w.w = pk2(yb.z, yb.w);
        *(v4u*)(MIXED + (row0 + q) * D + goff + 8 * lane) = w; }
    __syncthreads();
}
__device__ __forceinline__ void phase_attention(const Ptrs& P, unsigned char* lds, int lane, int wave) {
    const bf16* PROJ = (const bf16*)(P.ws + WS_PROJ); const bf16* VT = (const bf16*)(P.ws + WS_VT); bf16* MIXED = (bf16*)(P.ws + WS_MIXED);
    float* stage = (float*)lds; const int r32 = lane & 31, hi = lane >> 5;
    for (int idx = blockIdx.x; idx < 1024; idx += gridDim.x) {
        const int grp = idx >> 9, tile = idx & 511; const int b = tile >> 8, q0 = (tile & 255) * 32; const size_t rowbase = (size_t)b * SEQ;
        f32x16 o[2]; o[0] = f32x16{}; o[1] = f32x16{}; bf16x8 qf[4]; KVf cur, nxt;
        if (grp == 0) {
            const bf16* Qp = PROJ + (rowbase + q0 + r32) * NQK + wave * 64 + 8 * hi;
#pragma unroll
            for (int d0 = 0; d0 < 4; ++d0) qf[d0] = *(const bf16x8*)(Qp + 16 * d0);
            const bf16* Kp = PROJ + (size_t)r32 * NQK + 512 + wave * 64 + 8 * hi; const bf16* Vp = VT + (size_t)(wave * 64 + r32) * M + 4 * hi;
            float c_run = 0.f;
            load_kv(cur, Kp, Vp, rowbase + q0);
            if (q0 >= 32) load_kv(nxt, Kp, Vp, rowbase + q0 - 32);
            sb_step<true>(cur, qf, o, c_run, r32, hi);
            for (int k0 = q0 - 32; k0 >= 0; k0 -= 32) {
                if (__all(c_run >= SB_STOP)) break;
                cur = nxt;
                if (k0 >= 32) load_kv(nxt, Kp, Vp, rowbase + k0 - 32);
                sb_step<false>(cur, qf, o, c_run, r32, hi);
            }
            finish_unit(o, 1.0f, stage, wave, lane, rowbase + q0, P.gn_sb, MIXED, 0);
        } else {
            const int kvh = wave >> 2; const float slope2 = exp2f(-(float)(wave + 1)) * LOG2E;
            const bf16* Qp = PROJ + (rowbase + q0 + r32) * NQK + 1024 + wave * 64 + 8 * hi;
#pragma unroll
            for (int d0 = 0; d0 < 4; ++d0) qf[d0] = *(const bf16x8*)(Qp + 16 * d0);
            const bf16* Kp = PROJ + (size_t)r32 * NQK + 1536 + kvh * 64 + 8 * hi; const bf16* Vp = VT + (size_t)(512 + kvh * 64 + r32) * M + 4 * hi;
            float m_run = P.sinks[wave] * LOG2E, l_run = (hi == 0) ? 1.0f : 0.0f;
            const int kfirst = q0 >= 128 ? q0 - 128 : 0;
            load_kv(cur, Kp, Vp, rowbase + kfirst);
            for (int k0 = kfirst; k0 <= q0; k0 += 32) {
                if (k0 + 32 <= q0) load_kv(nxt, Kp, Vp, rowbase + k0 + 32);
                swa_step(cur, qf, o, m_run, l_run, slope2, q0 + r32 - k0, hi);
                cur = nxt;
            }
            const float l = l_run + __shfl_xor(l_run, 32);
            finish_unit(o, 1.0f / l, stage, wave, lane, rowbase + q0, P.gn_swa, MIXED, 512);
        }
    }
}

struct Args { const float* in[16]; float* out; unsigned char* ws; int ph_lo, ph_hi; };
constexpr int NPHASE = 9;
__global__ void __launch_bounds__(NWAVES * 64, 2) hymba_fwd(Args args) {
    extern __shared__ __attribute__((aligned(16))) unsigned char lds[];
    const int tid = threadIdx.x, lane = tid & 63, wave = __builtin_amdgcn_readfirstlane(tid >> 6);
    Ptrs P; P.x = args.in[0]; P.c = args.in[1]; P.w_ada = args.in[2]; P.b_ada = args.in[3]; P.w_in = args.in[4]; P.b_in = args.in[5]; P.sinks = args.in[6]; P.gn_sb = args.in[7];
    P.gn_swa = args.in[8]; P.w_out = args.in[9]; P.ln1_g = args.in[10]; P.ln1_b = args.in[11]; P.w_gu = args.in[12]; P.w_down = args.in[13]; P.ln2_g = args.in[14]; P.ln2_b = args.in[15];
    P.out = args.out; P.ws = args.ws;
    unsigned char* ws = args.ws; const int lo = args.ph_lo, hi = args.ph_hi; const int G = gridDim.x, c = blockIdx.x;
    PG8_LAS unsigned char* glds = (PG8_LAS unsigned char*)lds;
#define IN(k) (lo <= (k) && (k) < hi)
#define SEAM(k) do { if (IN(k) && IN((k) + 1)) { cg::this_grid().sync(); } } while (0)
    if (IN(0)) { phase_weights(P, lds, tid, lane, wave); } SEAM(0);
    if (IN(1)) { phase_mod_rows(P, lane, wave); } SEAM(1);
    if (IN(2)) {
        { pg8::Gemm g{(const bf16*)(ws + WS_XN), (const bf16*)(ws + WS_WQK), M, NQK, D}; pg8::StaticOrder S; S.init(M, NQK, G, c);
          pg8::EpiBf16<0> E{(bf16*)(ws + WS_PROJ), NQK, (const float*)(ws + WS_BQK), 0, 0, 1.f};
          pg8::gemm_phase<pg8::EpiBf16<0>, pg8::StaticOrder, true, true>(glds, g, S, E); }
        { pg8::Gemm g{(const bf16*)(ws + WS_WV), (const bf16*)(ws + WS_XN), NVT, M, D}; pg8::StaticOrder S; S.init(NVT, M, G, G - 1 - c);
          pg8::EpiVt E{(bf16*)(ws + WS_VT), M, (const float*)(ws + WS_BVT)};
          pg8::gemm_phase<pg8::EpiVt, pg8::StaticOrder, true, true>(glds, g, S, E); }
    } SEAM(2);
    if (IN(3)) { phase_attention(P, lds, lane, wave); } SEAM(3);
    if (IN(4)) {
        pg8::Gemm g{(const bf16*)(ws + WS_MIXED), (const bf16*)(ws + WS_WOUT), M, D, D}; pg8::StaticOrder S; S.init(M, D, G, c);
        pg8::EpiRes E{P.x, (float*)(ws + WS_Y), (const float*)(ws + WS_MOD) + 2 * D, DN_ALPHA};
        pg8::gemm_phase<pg8::EpiRes, pg8::StaticOrder, true, true>(glds, g, S, E);
    } SEAM(4);
    if (IN(5)) { phase_ln_rows<true>(P, (const float*)(ws + WS_Y), P.ln1_g, P.ln1_b, P.out, lane, wave); } SEAM(5);
    if (IN(6)) {
        pg8::Gemm g{(const bf16*)(ws + WS_XN), (const bf16*)(ws + WS_WGU), M, NGU, D}; pg8::StaticOrder S; S.init(M, NGU, G, c);
        pg8::EpiGU E{(bf16*)(ws + WS_HMID), DFF};
        pg8::gemm_phase<pg8::EpiGU, pg8::StaticOrder, true, true>(glds, g, S, E);
    } SEAM(6);
    if (IN(7)) {
        pg8::Gemm g{(const bf16*)(ws + WS_HMID), (const bf16*)(ws + WS_WDOWN), M, D, DFF}; pg8::StaticOrder S; S.init(M, D, G, c);
        pg8::EpiRes E{P.out, (float*)(ws + WS_Y), (const float*)(ws + WS_MOD) + 5 * D, DN_ALPHA};
        pg8::gemm_phase<pg8::EpiRes, pg8::StaticOrder, true, true>(glds, g, S, E);
    } SEAM(7);
    if (IN(8)) { phase_ln_rows<false>(P, (const float*)(ws + WS_Y), P.ln2_g, P.ln2_b, P.out, lane, wave); }
#undef IN
#undef SEAM
}

extern "C" void kernel_launch(void* const* d_in, const int* in_sizes, int n_in, void* d_out, int out_size, void* d_ws, size_t ws_size, hipStream_t stream) {
    static int grid = 0;
    if (grid == 0) {
        if (n_in != 16 || in_sizes[0] != M * D || out_size != M * D || ws_size < WS_END) { fprintf(stderr, "kernel_launch: unexpected shapes (n_in %d, in0 %d, out %d, ws %zu)\n", n_in, n_in > 0 ? in_sizes[0] : -1, out_size, ws_size); grid = -1; return; }
        int dev = 0, cus = 0, per_cu = 0;
        (void)hipGetDevice(&dev); (void)hipDeviceGetAttribute(&cus, hipDeviceAttributeMultiprocessorCount, dev);
        if (hipFuncSetAttribute((const void*)hymba_fwd, hipFuncAttributeMaxDynamicSharedMemorySize, LDS_BYTES) != hipSuccess) { fprintf(stderr, "kernel_launch: hipFuncSetAttribute failed\n"); grid = -1; return; }
        if (hipOccupancyMaxActiveBlocksPerMultiprocessor(&per_cu, (const void*)hymba_fwd, NWAVES * 64, LDS_BYTES) != hipSuccess || per_cu < 1) { fprintf(stderr, "kernel_launch: occupancy query says %d\n", per_cu); per_cu = 1; }
        (void)hipGetLastError();
        grid = cus * per_cu;
    }
    if (grid < 0) return;
    Args a{};
    for (int i = 0; i < 16; ++i) a.in[i] = (const float*)d_in[i];
    a.out = (float*)d_out; a.ws = (unsigned char*)d_ws;
#if MK_COOP
    a.ph_lo = 0; a.ph_hi = NPHASE;
    void* kargs[] = {&a};
    hipError_t e = hipLaunchCooperativeKernel((const void*)hymba_fwd, dim3(grid), dim3(NWAVES * 64), kargs, LDS_BYTES, stream);
    if (e != hipSuccess) fprintf(stderr, "cooperative launch failed: %s (grid %d)\n", hipGetErrorString(e), grid);
#else
    for (int ph = 0; ph < NPHASE; ++ph) { a.ph_lo = ph; a.ph_hi = ph + 1; hipLaunchKernelGGL(hymba_fwd, dim3(grid), dim3(NWAVES * 64), LDS_BYTES, stream, a); }
#endif
}
```

```cpp
#include <hip/hip_runtime.h>
#include <hip/hip_cooperative_groups.h>
#include <cstdio>
#include <cstdint>
namespace cg = cooperative_groups;
namespace pg8 {
#define PG8_LAS __attribute__((address_space(3)))
typedef unsigned short bf16_t;
typedef short bf16x8 __attribute__((ext_vector_type(8)));
typedef float f32x4 __attribute__((ext_vector_type(4)));
typedef unsigned u32x4 __attribute__((ext_vector_type(4)));
constexpr int BM = 256, BK = 64, HALF = 128, HTB = HALF * BK * 2  , STAGE_BYTES = 8 * HTB, NXCD = 8, WGM = 8;

__host__ __device__ __forceinline__ int lds_byte(int r, int c) { const int st = (r >> 4) * 2 + (c >> 5), rr = r & 15, cc = c & 31, ob = rr * 64 + cc * 2; return st * 1024 + (ob ^ (((ob >> 9) & 1) << 5)); }
__host__ __device__ __forceinline__ void stage_rc(int b, int& R, int& C) { const int st = b / 1024, sb = b % 1024, swz = sb ^ (((sb >> 9) & 1) << 5); R = (st >> 1) * 16 + swz / 64; C = (st & 1) * 32 + (swz % 64) / 2; }
__host__ __device__ __forceinline__ int perm32(int rho) { const int n = rho >> 4, i = rho & 15; return 8 * (i >> 2) + 4 * n + (i & 3); }

struct Unit { int pm, pn; };
struct Gemm { const bf16_t* A; const bf16_t* Bt; int M, N, K; };

struct StaticOrder {
    int nM, nN, nwg, G, c;
    __host__ __device__ void init(int M, int N, int G_, int c_) { nM = M / BM; nN = N / BM; nwg = nM * nN; G = G_; c = c_; }
    __host__ __device__ bool next(int i, Unit& u) const {
        const long L = (long)i * G + c; if (L >= nwg) return false;
        int wgid = (int)L; { const int q = nwg / NXCD, r = nwg % NXCD, xcd = wgid % NXCD, off = wgid / NXCD; wgid = (xcd < r ? xcd * (q + 1) : r * (q + 1) + (xcd - r) * q) + off; }
        const int nig = WGM * nN, gid = wgid / nig, fm = gid * WGM, gsz = (nM - fm) < WGM ? (nM - fm) : WGM;
        u.pm = fm + ((wgid % nig) % gsz); u.pn = (wgid % nig) / gsz; return true;
    }
    __device__ __forceinline__ void a_ready(const Unit&) const {}
    __device__ __forceinline__ void done(const Unit&) const {}
};

__device__ __forceinline__ unsigned cvt_pk_bf16(float lo, float hi) { unsigned r; asm volatile("v_cvt_pk_bf16_f32 %0, %1, %2" : "=v"(r) : "v"(lo), "v"(hi)); return r; }
typedef float f32x2 __attribute__((ext_vector_type(2)));
__device__ __forceinline__ f32x2 gelu_pk(f32x2 v) {
    const f32x2 av = __builtin_elementwise_abs(v), d = av * 0.2316418882f + 1.0f;
    f32x2 t; t.x = __builtin_amdgcn_rcpf(d.x); t.y = __builtin_amdgcn_rcpf(d.y);
    f32x2 q = t * 0.5307027145f + (-0.7265760135f); q = q * t + 0.7107068705f; q = q * t + (-0.142248368f); q = q * t + 0.127414796f; q = q * t;
    const f32x2 s = (v * v) * (-0.72134752044f);
    f32x2 e; e.x = __builtin_amdgcn_exp2f(s.x); e.y = __builtin_amdgcn_exp2f(s.y);
    const f32x2 m = v * (q * e), r = v - m;
    f32x2 o; o.x = v.x < 0.f ? m.x : r.x; o.y = v.y < 0.f ? m.y : r.y; return o;
}

template <int ACT  > struct EpiBf16 {
    static constexpr bool PERM = true, AFTER_DRAIN = false; static_assert(ACT == 0 || ACT == 1, "EpiBf16: ACT is 0 (none) or 1 (gelu_pk)");
    bf16_t* O; int ldc; const float* bias; int split_cols; size_t split_stride; float scale0;
    __device__ __forceinline__ void operator()(const f32x4 (&acc)[2][2][4][2], const Unit& u, int wr, int wc, int fr, int fq) const {
        const int row0 = u.pm * BM + wr * 64 + fr; int colt = u.pn * BM; bf16_t* base = O;
        float sc = 1.f; if (split_cols) { const int t = colt / split_cols; base += (size_t)t * split_stride; colt -= t * split_cols; if (t == 0) sc = scale0; }
        const int col0 = colt + wc * 32 + 8 * fq, bcol0 = u.pn * BM + wc * 32 + 8 * fq;
        f32x4 bv[2][2];
#pragma unroll
        for (int bj = 0; bj < 2; ++bj)
#pragma unroll
            for (int n = 0; n < 2; ++n) bv[bj][n] = bias ? *(const f32x4*)(bias + bcol0 + bj * HALF + 4 * n) : (f32x4){0.f, 0.f, 0.f, 0.f};
#pragma unroll
        for (int ai = 0; ai < 2; ++ai)
#pragma unroll
            for (int m = 0; m < 4; ++m) { bf16_t* rowp = base + (size_t)(row0 + ai * HALF + m * 16) * ldc + col0;
#pragma unroll
                for (int bj = 0; bj < 2; ++bj) { f32x4 v0 = acc[ai][bj][m][0] + bv[bj][0], v1 = acc[ai][bj][m][1] + bv[bj][1];
                    if (ACT == 1) { f32x2 a = gelu_pk((f32x2){v0[0], v0[1]}), b = gelu_pk((f32x2){v0[2], v0[3]}), c = gelu_pk((f32x2){v1[0], v1[1]}), d = gelu_pk((f32x2){v1[2], v1[3]});
                        v0 = (f32x4){a.x, a.y, b.x, b.y}; v1 = (f32x4){c.x, c.y, d.x, d.y}; }
                    v0 = v0 * sc; v1 = v1 * sc; u32x4 w; w.x = cvt_pk_bf16(v0[0], v0[1]); w.y = cvt_pk_bf16(v0[2], v0[3]); w.z = cvt_pk_bf16(v1[0], v1[1]); w.w = cvt_pk_bf16(v1[2], v1[3]);
                    *(u32x4*)(rowp + bj * HALF) = w; } }
    }
};
template <class Epi, class Sched, bool ALIGN_EPI = false, bool SP2 = false>
__device__ __forceinline__ void gemm_phase(PG8_LAS unsigned char* lds, const Gemm g, const Sched& S, const Epi& E) {
    const int tid = threadIdx.x, wid = __builtin_amdgcn_readfirstlane(tid >> 6), lane = tid & 63, wr = wid >> 2, wc = wid & 3, fr = lane & 15, fq = lane >> 4;
    const int K = g.K, nt = K / BK;
    unsigned voffA[2], voffB[2];
#pragma unroll
    for (int i = 0; i < 2; ++i) { int R, C; stage_rc(tid * 16 + i * 8192, R, C); const int Rb = Epi::PERM ? ((R & ~31) + perm32(R & 31)) : R;
        voffA[i] = (unsigned)(R * K + C) * 2u; voffB[i] = (unsigned)(Rb * K + C) * 2u; }
    const size_t kstep = (size_t)(BK * 2);
    const size_t hstep = (size_t)HALF * K * 2;
    const size_t tstep = 2 * hstep;
    const unsigned ldsw = (unsigned)wid * 1024u;
    const int aoff = lds_byte(wr * 64 + fr, fq * 8), boff = lds_byte(wc * 32 + fr, fq * 8);
#define PG8_SA(b, h) (((b) * 2 + (h)) * HTB)
#define PG8_SB(b, h) ((4 + (b) * 2 + (h)) * HTB)
#define PG8_STAGE(bufoff, gbase, voff) do { _Pragma("unroll") for (int _i = 0; _i < 2; ++_i) \
        __builtin_amdgcn_global_load_lds((const unsigned*)((const char*)(gbase) + (voff)[_i]), (PG8_LAS unsigned*)(lds + (bufoff) + ldsw + _i * 8192), 16, 0, 0); } while (0)
#define PG8_LDA(dst, b, h) do { _Pragma("unroll") for (int m = 0; m < 4; ++m) _Pragma("unroll") for (int k = 0; k < 2; ++k) dst[m][k] = *(const PG8_LAS bf16x8*)(lds + PG8_SA(b, h) + aoff + m * 2048 + k * 1024); } while (0)
#define PG8_LDB(dst, b, h) do { _Pragma("unroll") for (int n = 0; n < 2; ++n) _Pragma("unroll") for (int k = 0; k < 2; ++k) dst[n][k] = *(const PG8_LAS bf16x8*)(lds + PG8_SB(b, h) + boff + n * 2048 + k * 1024); } while (0)
#define PG8_MMA(ai, bj, At, Bt) do { __builtin_amdgcn_s_setprio(1); _Pragma("unroll") for (int m = 0; m < 4; ++m) _Pragma("unroll") for (int n = 0; n < 2; ++n) _Pragma("unroll") for (int k = 0; k < 2; ++k) \
        acc[ai][bj][m][n] = __builtin_amdgcn_mfma_f32_16x16x32_bf16(Bt[n][k], At[m][k], acc[ai][bj][m][n], 0, 0, 0); __builtin_amdgcn_s_setprio(0); } while (0)
#define PG8_WAIT_V(n) asm volatile("s_waitcnt vmcnt(" #n ")" ::: "memory")
#define PG8_WAIT_L(n) asm volatile("s_waitcnt lgkmcnt(" #n ")" ::: "memory")
#define PG8_BAR __builtin_amdgcn_s_barrier()
#define PG8_SCHED __builtin_amdgcn_sched_barrier(0)
    Unit cur, nxt; int ui = 0;
    if (!S.next(0, cur)) return;
    f32x4 acc[2][2][4][2];
#pragma unroll
    for (int a = 0; a < 2; ++a)
#pragma unroll
        for (int b = 0; b < 2; ++b)
#pragma unroll
            for (int m = 0; m < 4; ++m)
#pragma unroll
                for (int n = 0; n < 2; ++n) acc[a][b][m][n] = (f32x4){0.f, 0.f, 0.f, 0.f};
    bf16x8 At[4][2], B0[2][2], B1[2][2];
    const char* cA = (const char*)g.A + (size_t)cur.pm * tstep; const char* cB = (const char*)g.Bt + (size_t)cur.pn * tstep;
    S.a_ready(cur);
    if constexpr (SP2) {
        PG8_STAGE(PG8_SB(0, 0), cB, voffB); PG8_STAGE(PG8_SB(0, 1), cB + hstep, voffB); PG8_STAGE(PG8_SA(0, 0), cA, voffA); PG8_STAGE(PG8_SA(0, 1), cA + hstep, voffA);
        if (wr == 1) PG8_BAR;
        PG8_WAIT_V(2); PG8_BAR;
        PG8_STAGE(PG8_SB(1, 0), cB + kstep, voffB); PG8_STAGE(PG8_SA(1, 0), cA + kstep, voffA); PG8_STAGE(PG8_SB(1, 1), cB + hstep + kstep, voffB);
        PG8_WAIT_V(6); PG8_BAR;
    } else {
        PG8_STAGE(PG8_SB(0, 0), cB, voffB); PG8_STAGE(PG8_SA(0, 0), cA, voffA); PG8_STAGE(PG8_SB(0, 1), cB + hstep, voffB); PG8_STAGE(PG8_SA(0, 1), cA + hstep, voffA);
        if (wr == 1) PG8_BAR;
        PG8_WAIT_V(4); PG8_BAR;
        PG8_STAGE(PG8_SB(1, 0), cB + kstep, voffB); PG8_STAGE(PG8_SA(1, 0), cA + kstep, voffA); PG8_STAGE(PG8_SB(1, 1), cB + hstep + kstep, voffB);
        PG8_WAIT_V(6); PG8_BAR;
    }
    for (;;) {
        const bool has_next = S.next(ui + 1, nxt);
        const char* nA = has_next ? (const char*)g.A + (size_t)nxt.pm * tstep : cA; const char* nB = has_next ? (const char*)g.Bt + (size_t)nxt.pn * tstep : cB;
        for (int t = 0; t < nt; t += 2) {
            const bool last = (t == nt - 2);
            const char* a1 = cA + (size_t)(t + 1) * kstep;
            const char* a2 = last ? nA : cA + (size_t)(t + 2) * kstep; const char* b2 = last ? nB : cB + (size_t)(t + 2) * kstep;
            const char* a3 = a2 + kstep; const char* b3 = b2 + kstep;
            if (last && has_next) S.a_ready(nxt);
            if constexpr (SP2) {
            PG8_LDB(B0, 0, 0); PG8_LDB(B1, 0, 1); PG8_SCHED; PG8_LDA(At, 0, 0); PG8_STAGE(PG8_SA(1, 1), a1 + hstep, voffA);
            PG8_WAIT_V(8); PG8_WAIT_L(0); PG8_BAR; PG8_MMA(0, 0, At, B0); PG8_MMA(0, 1, At, B1); PG8_BAR; PG8_SCHED;
            PG8_LDA(At, 0, 1); PG8_STAGE(PG8_SB(0, 0), b2, voffB); PG8_STAGE(PG8_SB(0, 1), b2 + hstep, voffB); PG8_STAGE(PG8_SA(0, 0), a2, voffA);
            PG8_WAIT_V(8); PG8_WAIT_L(0); PG8_BAR; PG8_MMA(1, 0, At, B0); PG8_MMA(1, 1, At, B1); PG8_BAR; PG8_SCHED;
            PG8_LDB(B0, 1, 0); PG8_LDB(B1, 1, 1); PG8_SCHED; PG8_LDA(At, 1, 0); PG8_STAGE(PG8_SA(0, 1), a2 + hstep, voffA);
            PG8_WAIT_V(8); PG8_WAIT_L(0); PG8_BAR; PG8_MMA(0, 0, At, B0); PG8_MMA(0, 1, At, B1); PG8_BAR; PG8_SCHED;
            PG8_LDA(At, 1, 1); PG8_STAGE(PG8_SB(1, 0), b3, voffB); PG8_STAGE(PG8_SB(1, 1), b3 + hstep, voffB); PG8_STAGE(PG8_SA(1, 0), a3, voffA);
            PG8_WAIT_V(8); PG8_WAIT_L(0); PG8_BAR; PG8_MMA(1, 0, At, B0); PG8_MMA(1, 1, At, B1); PG8_BAR; PG8_SCHED;
            } else {
            PG8_LDB(B0, 0, 0); PG8_SCHED; PG8_LDA(At, 0, 0); PG8_STAGE(PG8_SA(1, 1), a1 + hstep, voffA);
            PG8_WAIT_L(8); PG8_BAR; PG8_WAIT_L(0); PG8_MMA(0, 0, At, B0); PG8_BAR; PG8_SCHED;
            PG8_LDB(B1, 0, 1); PG8_STAGE(PG8_SB(0, 0), b2, voffB);
            PG8_BAR; PG8_WAIT_L(0); PG8_MMA(0, 1, At, B1); PG8_BAR;
            PG8_LDA(At, 0, 1); PG8_STAGE(PG8_SA(0, 0), a2, voffA);
            PG8_BAR; PG8_WAIT_L(0); PG8_MMA(1, 0, At, B0); PG8_BAR; PG8_SCHED;
            PG8_STAGE(PG8_SB(0, 1), b2 + hstep, voffB);
            PG8_WAIT_V(6); PG8_BAR; PG8_MMA(1, 1, At, B1); PG8_BAR;
            PG8_LDB(B0, 1, 0); PG8_SCHED; PG8_LDA(At, 1, 0); PG8_STAGE(PG8_SA(0, 1), a2 + hstep, voffA);
            PG8_WAIT_L(8); PG8_BAR; PG8_WAIT_L(0); PG8_MMA(0, 0, At, B0); PG8_BAR; PG8_SCHED;
            PG8_LDB(B1, 1, 1); PG8_STAGE(PG8_SB(1, 0), b3, voffB);
            PG8_BAR; PG8_WAIT_L(0); PG8_MMA(0, 1, At, B1); PG8_BAR;
            PG8_LDA(At, 1, 1); PG8_STAGE(PG8_SA(1, 0), a3, voffA);
            PG8_BAR; PG8_WAIT_L(0); PG8_MMA(1, 0, At, B0); PG8_BAR; PG8_SCHED;
            PG8_STAGE(PG8_SB(1, 1), b3 + hstep, voffB);
            PG8_WAIT_V(6); PG8_BAR; PG8_MMA(1, 1, At, B1); PG8_BAR;
            }
        }
        if constexpr (ALIGN_EPI) { if (wr == 0) PG8_BAR; }
        if constexpr (!Epi::AFTER_DRAIN) { E(acc, cur, wr, wc, fr, fq); S.done(cur); }
        if (!has_next) break;
#pragma unroll
        for (int a = 0; a < 2; ++a)
#pragma unroll
            for (int b = 0; b < 2; ++b)
#pragma unroll
                for (int m = 0; m < 4; ++m)
#pragma unroll
                    for (int n = 0; n < 2; ++n) acc[a][b][m][n] = (f32x4){0.f, 0.f, 0.f, 0.f};
        cur = nxt; cA = nA; cB = nB; ++ui;
        if constexpr (ALIGN_EPI) { if (wr == 1) PG8_BAR; }
    }
    PG8_WAIT_V(0);
    if constexpr (!ALIGN_EPI) { if (wr == 0) PG8_BAR; }
    PG8_BAR;
    if constexpr (Epi::AFTER_DRAIN) { E.fused(acc, cur, wr, wc, fr, fq, lds, wid, lane); S.done(cur); }
#undef PG8_SA
#undef PG8_SB
#undef PG8_STAGE
#undef PG8_LDA
#undef PG8_LDB
#undef PG8_MMA
#undef PG8_WAIT_V
#undef PG8_WAIT_L
#undef PG8_BAR
#undef PG8_SCHED
}
}
namespace pg8 {
typedef float f32x2e __attribute__((ext_vector_type(2))); typedef __bf16 bf16x2e __attribute__((ext_vector_type(2)));
__device__ __forceinline__ unsigned pkbf(float lo, float hi) { f32x2e v = {lo, hi}; bf16x2e b = __builtin_convertvector(v, bf16x2e); return __builtin_bit_cast(unsigned, b); }
struct EpiVt {
    static constexpr bool PERM = true, AFTER_DRAIN = false;
    bf16_t* O; int ldc; const float* biasrow;
    __device__ __forceinline__ void operator()(const f32x4 (&acc)[2][2][4][2], const Unit& u, int wr, int wc, int fr, int fq) const {
        const int row0 = u.pm * BM + wr * 64 + fr, col0 = u.pn * BM + wc * 32 + 8 * fq;
#pragma unroll
        for (int ai = 0; ai < 2; ++ai)
#pragma unroll
            for (int m = 0; m < 4; ++m) { const int r = row0 + ai * HALF + m * 16; const float b = biasrow[r]; bf16_t* rowp = O + ((size_t)(col0 >> 5) * 768 + r) * 32 + (col0 & 31);
#pragma unroll
                for (int bj = 0; bj < 2; ++bj) { const f32x4 v0 = acc[ai][bj][m][0] + b, v1 = acc[ai][bj][m][1] + b;
                    u32x4 w; w.x = pkbf(v0[0], v0[1]); w.y = pkbf(v0[2], v0[3]); w.z = pkbf(v1[0], v1[1]); w.w = pkbf(v1[2], v1[3]);
                    *(u32x4*)(rowp + (size_t)bj * (HALF / 32) * 768 * 32) = w; } }
    }
};
struct EpiRes {
    static constexpr bool PERM = false, AFTER_DRAIN = false;
    const float* X; float* Y; const float* gate; float alpha;
    __device__ __forceinline__ void operator()(const f32x4 (&acc)[2][2][4][2], const Unit& u, int wr, int wc, int fr, int fq) const {
        const int col0 = u.pn * BM + wc * 32 + 4 * fq; const int b = (u.pm * BM) >> 13;
        f32x4 gv[2][2];
#pragma unroll
        for (int bj = 0; bj < 2; ++bj)
#pragma unroll
            for (int n = 0; n < 2; ++n) gv[bj][n] = *(const f32x4*)(gate + b * 6144 + col0 + bj * HALF + n * 16) + 1.0f;
#pragma unroll
        for (int ai = 0; ai < 2; ++ai)
#pragma unroll
            for (int m = 0; m < 4; ++m) { const int r = u.pm * BM + ai * HALF + wr * 64 + m * 16 + fr; const size_t off = (size_t)r * 1024 + col0;
#pragma unroll
                for (int bj = 0; bj < 2; ++bj)
#pragma unroll
                    for (int n = 0; n < 2; ++n) { const f32x4 xv = *(const f32x4*)(X + off + bj * HALF + n * 16);
                        *(f32x4*)(Y + off + bj * HALF + n * 16) = xv * alpha + gv[bj][n] * acc[ai][bj][m][n]; } }
    }
};
struct EpiGU {
    static constexpr bool PERM = true, AFTER_DRAIN = false;
    bf16_t* H; int ldc;
    __device__ __forceinline__ void operator()(const f32x4 (&acc)[2][2][4][2], const Unit& u, int wr, int wc, int fr, int fq) const {
        const int row0 = u.pm * BM + wr * 64 + fr, col0 = u.pn * HALF + wc * 32 + 8 * fq;
#pragma unroll
        for (int ai = 0; ai < 2; ++ai)
#pragma unroll
            for (int m = 0; m < 4; ++m) { bf16_t* rowp = H + (size_t)(row0 + ai * HALF + m * 16) * ldc + col0;
                float h[8];
#pragma unroll
                for (int n = 0; n < 2; ++n)
#pragma unroll
                    for (int e = 0; e < 4; ++e) { const float g = acc[ai][0][m][n][e], up = acc[ai][1][m][n][e];
                        const float sg = g * __builtin_amdgcn_rcpf(1.0f + __builtin_amdgcn_exp2f(-1.4426950408889634f * g)); h[4 * n + e] = sg * up; }
                u32x4 w; w.x = pkbf(h[0], h[1]); w.y = pkbf(h[2], h[3]); w.z = pkbf(h[4], h[5]); w.w = pkbf(h[6], h[7]);
                *(u32x4*)rowp = w; }
    }
};
}
#ifndef MK_COOP
#define MK_COOP 1
#endif
typedef unsigned short bf16;
typedef float f32x4 __attribute__((ext_vector_type(4)));
typedef float f32x16 __attribute__((ext_vector_type(16)));
typedef short bf16x8 __attribute__((ext_vector_type(8)));
typedef short s16x4 __attribute__((ext_vector_type(4)));
typedef unsigned v4u __attribute__((ext_vector_type(4)));
typedef unsigned v2u __attribute__((ext_vector_type(2)));
#define LAS __attribute__((address_space(3)))
constexpr int SEQ = 8192, M = 16384, D = 1024, NQK = 1792, NVT = 768, DFF = 2816, NGU = 5632, NMOD = 6144, DIN = 2304;
constexpr float LOG2E = 1.4426950408889634f, SC2 = 0.125f * LOG2E;
constexpr float DN_ALPHA = 1.189207115002721f;
constexpr float SB_STOP = 151.0f;
constexpr size_t MiB = 1u << 20;
constexpr size_t WS_MOD = 0, WS_BQK = 64 * 1024, WS_BVT = 80 * 1024, WS_BAR = 128 * 1024, BAR_BYTES = 16 * 1024;
constexpr size_t WS_WQK = 1 * MiB, WS_WV = 5 * MiB, WS_WOUT = 7 * MiB, WS_WGU = 9 * MiB, WS_WDOWN = 20 * MiB;
constexpr size_t WS_XN = 26 * MiB, WS_PROJ = 58 * MiB, WS_VT = 114 * MiB, WS_MIXED = 138 * MiB, WS_Y = 170 * MiB, WS_HMID = 58 * MiB, WS_END = 234 * MiB;
static_assert(WS_HMID + (size_t)M * DFF * 2 <= WS_Y, "hmid overlays proj/vt/mixed only");
constexpr int LDS_BYTES = 147456;
constexpr int NWAVES = 8;
constexpr int BAR_LDS_OFF = 131072 + 8192;

__device__ __forceinline__ unsigned pk2(float lo, float hi) { return pg8::pkbf(lo, hi); }
__device__ __forceinline__ float wave_sum(float v) {
#pragma unroll
    for (int o = 1; o < 64; o <<= 1) v += __shfl_xor(v, o);
    return v;
}

#define XB_TMO      128
#define XB_XCNT(j)  (256  + 64 * (j))
#define XB_XSUB(j)  (1280 + 64 * (j))
#define XB_XGEN(j)  (2304 + 64 * (j))
#define XB_TOP      3328
#define XB_TOPGEN   3392
#define XCD_BAR_WORDS 3456
#define XB_SPIN_CAP (1u << 18)

__device__ __forceinline__ unsigned xb_ld(unsigned* p)              { return __hip_atomic_load(p, __ATOMIC_RELAXED, __HIP_MEMORY_SCOPE_AGENT); }
__device__ __forceinline__ unsigned xb_add(unsigned* p, unsigned v) { return __hip_atomic_fetch_add(p, v, __ATOMIC_RELAXED, __HIP_MEMORY_SCOPE_AGENT); }
__device__ __forceinline__ unsigned xb_xcc_id() { return (unsigned)__builtin_amdgcn_s_getreg((3 << 11) | 20) & 0xFu; }
#define XB_SPIN(cond, bar) do { unsigned _sp = 0; while (cond) { __builtin_amdgcn_s_sleep(1); \
    if ((++_sp & 255u) == 0u) { if (xb_ld(&(bar)[XB_TMO])) break; if (_sp > XB_SPIN_CAP) { atomicAdd(&(bar)[XB_TMO], 1u); break; } } } } while (0)

struct XcdBarrier {
    unsigned* bar; unsigned x;
    volatile LAS unsigned* st;
};

__device__ __forceinline__ XcdBarrier xcd_barrier_post(unsigned* bar, volatile LAS unsigned* st) {
    XcdBarrier b; b.bar = bar; b.x = xb_xcc_id(); b.st = st;
    if (threadIdx.x == 0) (void)xb_add(&bar[XB_XCNT(b.x)], 1u);
    return b;
}
__device__ __forceinline__ void xcd_barrier_complete(unsigned* bar, unsigned x, unsigned& nloc, unsigned& nx) {
    const unsigned G = gridDim.x * gridDim.y * gridDim.z;
    unsigned sum, cnt, mine, sp = 0u;
    for (;;) {
        sum = 0u; cnt = 0u; mine = 0u;
#pragma unroll
        for (unsigned j = 0; j < 16; ++j) { const unsigned c = xb_ld(&bar[XB_XCNT(j)]); sum += c; cnt += (c > 0u) ? 1u : 0u; mine = (j == x) ? c : mine; }
        if (sum == G) break;
        __builtin_amdgcn_s_sleep(1);
        if ((++sp & 255u) == 0u) { if (xb_ld(&bar[XB_TMO])) break; if (sp > XB_SPIN_CAP) { atomicAdd(&bar[XB_TMO], 1u); break; } }
    }
    nloc = mine > 0u ? mine : 1u; nx = cnt > 0u ? cnt : 1u;
}

__device__ __forceinline__ void xcd_barrier(const XcdBarrier& b) {
    asm volatile("s_waitcnt vmcnt(0)" ::: "memory");
    __syncthreads();
    if (threadIdx.x == 0) {
        unsigned* bar = b.bar;
        __builtin_amdgcn_s_waitcnt(0);
        unsigned nloc = b.st[0], nx = b.st[1];
        if (nloc == 0u) { xcd_barrier_complete(bar, b.x, nloc, nx); b.st[0] = nloc; b.st[1] = nx; }
        const unsigned old = xb_add(&bar[XB_XSUB(b.x)], 1u);
        const unsigned gen = old / nloc;
        if (old + 1u == (gen + 1u) * nloc) {
            __builtin_amdgcn_fence(__ATOMIC_RELEASE, "agent");
            asm volatile("s_waitcnt vmcnt(0)" ::: "memory");
            const unsigned og = xb_add(&bar[XB_TOP], 1u);
            const unsigned tg = og / nx;
            if (og + 1u == (tg + 1u) * nx) xb_add(&bar[XB_TOPGEN], 1u);
            else XB_SPIN(xb_ld(&bar[XB_TOPGEN]) == tg, bar);
            __builtin_amdgcn_fence(__ATOMIC_ACQUIRE, "agent");
            xb_add(&bar[XB_XGEN(b.x)], 1u);
            asm volatile("s_waitcnt vmcnt(0)" ::: "memory");
        } else {
            XB_SPIN(xb_ld(&bar[XB_XGEN(b.x)]) == gen, bar);
            __builtin_amdgcn_fence(__ATOMIC_ACQUIRE, "agent");
            asm volatile("s_waitcnt vmcnt(0)" ::: "memory");
        }
    }
    __syncthreads();
}

__device__ __forceinline__ void tr_item(const float* __restrict__ W, int ldw, int k0, int c0, bf16* WT, int ldt, int drow0, float* scr, int lane) {
#pragma unroll 8
    for (int i = 0; i < 32; ++i) { const int kk = 2 * i + (lane >> 5); scr[kk * 33 + (lane & 31)] = W[(size_t)(k0 + kk) * ldw + c0 + (lane & 31)]; }
    asm volatile("s_waitcnt lgkmcnt(0)" ::: "memory");
    const int c = lane & 7;
#pragma unroll
    for (int j = 0; j < 4; ++j) { const int n = (lane >> 3) + 8 * j; const float* s = scr + (8 * c) * 33 + n;
        v4u o; o.x = pk2(s[0 * 33], s[1 * 33]); o.y = pk2(s[2 * 33], s[3 * 33]); o.z = pk2(s[4 * 33], s[5 * 33]); o.w = pk2(s[6 * 33], s[7 * 33]);
        *(v4u*)(WT + (size_t)(drow0 + n) * ldt + k0 + 8 * c) = o; }
    asm volatile("s_waitcnt lgkmcnt(0)" ::: "memory");
}

struct Ptrs {
    const float *x, *c, *w_ada, *b_ada, *w_in, *b_in, *sinks, *gn_sb, *gn_swa, *w_out, *ln1_g, *ln1_b, *w_gu, *w_down, *ln2_g, *ln2_b;
    float* out; unsigned char* ws;
};

__device__ __forceinline__ void phase_weights(const Ptrs& P, unsigned char* lds, int tid, int lane, int wave) {
    unsigned char* ws = P.ws;
    float* MOD = (float*)(ws + WS_MOD);
    for (int j = blockIdx.x; j < NMOD / 64; j += gridDim.x) {
        float* red = (float*)lds;
        const int col = 64 * j + lane; float a0 = 0.f, a1 = 0.f;
#pragma unroll 8
        for (int k = 128 * wave; k < 128 * wave + 128; ++k) {
            const float wv = P.w_ada[(size_t)k * NMOD + col]; const float c0 = P.c[k], c1 = P.c[D + k];
            a0 += (c0 / (1.0f + __expf(-c0))) * wv; a1 += (c1 / (1.0f + __expf(-c1))) * wv; }
        red[(wave * 2 + 0) * 64 + lane] = a0; red[(wave * 2 + 1) * 64 + lane] = a1;
        __syncthreads();
        if (tid < 128) { const int b = tid >> 6, l = tid & 63; float s = 0.f;
#pragma unroll
            for (int w = 0; w < 8; ++w) s += red[(w * 2 + b) * 64 + l];
            MOD[b * NMOD + 64 * j + l] = s + P.b_ada[64 * j + l]; }
        __syncthreads();
    }
    const int gt = blockIdx.x * 512 + tid, NGT = gridDim.x * 512;
    float* bqk = (float*)(ws + WS_BQK); float* bvt = (float*)(ws + WS_BVT);
    for (int i = gt; i < NQK; i += NGT) bqk[i] = i < 1024 ? P.b_in[i] : (i < 1664 ? P.b_in[i + 512] : 0.f);
    for (int i = gt; i < NVT; i += NGT) bvt[i] = i < 512 ? P.b_in[1024 + i] : (i < 640 ? P.b_in[2176 + i - 512] : 0.f);
    { v4u z = {0u, 0u, 0u, 0u}; v4u* p0 = (v4u*)((bf16*)(ws + WS_WQK) + (size_t)1664 * D); v4u* p1 = (v4u*)((bf16*)(ws + WS_WV) + (size_t)640 * D);
      for (int i = gt; i < 128 * D / 8; i += NGT) { p0[i] = z; p1[i] = z; } }
    float* scr = (float*)(lds + 4096 + wave * 8704);
    const int gw = blockIdx.x * NWAVES + wave, NGW = gridDim.x * NWAVES;
    constexpr int I_IN = 16 * 72, I_OUT = 16 * 32, I_GU = 16 * 176, I_DN = 44 * 32, NIT = I_IN + I_OUT + I_GU + I_DN;
    for (int it = gw; it < NIT; it += NGW) {
        int r = it;
        if (r < I_IN) { const int kb = r / 72, c0 = 32 * (r % 72); bf16* dst; int drow;
            if (c0 < 1024) { dst = (bf16*)(ws + WS_WQK); drow = c0; }
            else if (c0 < 1536) { dst = (bf16*)(ws + WS_WV); drow = c0 - 1024; }
            else if (c0 < 2176) { dst = (bf16*)(ws + WS_WQK); drow = c0 - 512; }
            else { dst = (bf16*)(ws + WS_WV); drow = c0 - 2176 + 512; }
            tr_item(P.w_in, DIN, 64 * kb, c0, dst, D, drow, scr, lane); continue; }
        r -= I_IN;
        if (r < I_OUT) { const int kb = r / 32, c0 = 32 * (r % 32); tr_item(P.w_out, D, 64 * kb, c0, (bf16*)(ws + WS_WOUT), D, c0, scr, lane); continue; }
        r -= I_OUT;
        if (r < I_GU) { const int kb = r / 176, c0 = 32 * (r % 176); const int cc = c0 < DFF ? c0 : c0 - DFF; const int drow = 256 * (cc / 128) + (cc % 128) + (c0 < DFF ? 0 : 128);
            tr_item(P.w_gu, NGU, 64 * kb, c0, (bf16*)(ws + WS_WGU), D, drow, scr, lane); continue; }
        r -= I_GU;
        { const int kb = r / 32, c0 = 32 * (r % 32); tr_item(P.w_down, D, 64 * kb, c0, (bf16*)(ws + WS_WDOWN), DFF, c0, scr, lane); }
    }
}

__device__ __forceinline__ void phase_mod_rows(const Ptrs& P, int lane, int wave) {
    const float* MOD = (const float*)(P.ws + WS_MOD); bf16* XN = (bf16*)(P.ws + WS_XN);
    const int gw = blockIdx.x * NWAVES + wave, NGW = gridDim.x * NWAVES;
    for (int m = gw; m < M; m += NGW) { const int b = m >> 13; const f32x4* xr = (const f32x4*)(P.x + (size_t)m * D) + lane;
        const f32x4* sh = (const f32x4*)(MOD + b * NMOD) + lane; const f32x4* sc = (const f32x4*)(MOD + b * NMOD + D) + lane;
        unsigned long long* o8 = (unsigned long long*)(XN + (size_t)m * D) + lane;
#pragma unroll
        for (int j = 0; j < 4; ++j) { const f32x4 v = xr[64 * j] * (sc[64 * j] + 1.0f) + sh[64 * j];
            o8[64 * j] = (unsigned long long)pk2(v.x, v.y) | ((unsigned long long)pk2(v.z, v.w) << 32); } }
}
template <bool WITH_XN> __device__ __forceinline__ void phase_ln_rows(const Ptrs& P, const float* Y, const float* g, const float* bta, float* X1, int lane, int wave) {
    const float* MOD = (const float*)(P.ws + WS_MOD); bf16* XN = (bf16*)(P.ws + WS_XN);
    const int gw = blockIdx.x * NWAVES + wave, NGW = gridDim.x * NWAVES;
    for (int m = gw; m < M; m += NGW) { const int b = m >> 13; const f32x4* yr = (const f32x4*)(Y + (size_t)m * D) + lane;
        f32x4 v[4]; float s = 0.f;
#pragma unroll
        for (int j = 0; j < 4; ++j) { v[j] = yr[64 * j]; s += (v[j].x + v[j].y) + (v[j].z + v[j].w); }
        const float mean = wave_sum(s) * (1.f / D); float s2 = 0.f;
#pragma unroll
        for (int j = 0; j < 4; ++j) { v[j] = v[j] - mean; s2 += (v[j].x * v[j].x + v[j].y * v[j].y) + (v[j].z * v[j].z + v[j].w * v[j].w); }
        const float rstd = 1.f / sqrtf(wave_sum(s2) * (1.f / D) + 1e-5f);
        f32x4* xo = (f32x4*)(X1 + (size_t)m * D) + lane;
        const f32x4* gg = (const f32x4*)g + lane; const f32x4* bb = (const f32x4*)bta + lane;
        const f32x4* sh = (const f32x4*)(MOD + b * NMOD + 3 * D) + lane; const f32x4* sc = (const f32x4*)(MOD + b * NMOD + 4 * D) + lane;
        unsigned long long* o8 = (unsigned long long*)(XN + (size_t)m * D) + lane;
#pragma unroll
        for (int j = 0; j < 4; ++j) { const f32x4 x1 = v[j] * rstd * gg[64 * j] + bb[64 * j]; xo[64 * j] = x1;
            if (WITH_XN) { const f32x4 h = x1 * (sc[64 * j] + 1.0f) + sh[64 * j]; o8[64 * j] = (unsigned long long)pk2(h.x, h.y) | ((unsigned long long)pk2(h.z, h.w) << 32); } } }
}

struct KVf { bf16x8 k[4]; bf16x8 v[2][2]; };
__device__ __forceinline__ void load_kv(KVf& f, const bf16* __restrict__ Kp, const bf16* __restrict__ Vp, size_t tok) {
#pragma unroll
    for (int d0 = 0; d0 < 4; ++d0) f.k[d0] = *(const bf16x8*)(Kp + tok * NQK + 16 * d0);
#pragma unroll
    for (int dt = 0; dt < 2; ++dt)
#pragma unroll
        for (int ks = 0; ks < 2; ++ks) { const bf16* p = Vp + (tok >> 5) * (size_t)(NVT * 32) + dt * 1024 + 16 * ks; const s16x4 lo = *(const s16x4*)p, hi4 = *(const s16x4*)(p + 8);
            f.v[dt][ks] = (bf16x8){lo[0], lo[1], lo[2], lo[3], hi4[0], hi4[1], hi4[2], hi4[3]}; }
}
__device__ __forceinline__ f32x16 qk_tile(const KVf& f, const bf16x8 (&qf)[4]) {
    f32x16 s = {};
#pragma unroll
    for (int d0 = 0; d0 < 4; ++d0) s = __builtin_amdgcn_mfma_f32_32x32x16_bf16(f.k[d0], qf[d0], s, 0, 0, 0);
    return s;
}
__device__ __forceinline__ void pv_tile(f32x16 (&o)[2], const KVf& f, const float (&w)[16]) {
    v4u p0, p1; p0.x = pk2(w[0], w[1]); p0.y = pk2(w[2], w[3]); p0.z = pk2(w[4], w[5]); p0.w = pk2(w[6], w[7]);
    p1.x = pk2(w[8], w[9]); p1.y = pk2(w[10], w[11]); p1.z = pk2(w[12], w[13]); p1.w = pk2(w[14], w[15]);
    const bf16x8 b0 = __builtin_bit_cast(bf16x8, p0), b1 = __builtin_bit_cast(bf16x8, p1);
#pragma unroll
    for (int dt = 0; dt < 2; ++dt) { o[dt] = __builtin_amdgcn_mfma_f32_32x32x16_bf16(f.v[dt][0], b0, o[dt], 0, 0, 0); o[dt] = __builtin_amdgcn_mfma_f32_32x32x16_bf16(f.v[dt][1], b1, o[dt], 0, 0, 0); }
}
template <bool DIAG> __device__ __forceinline__ void sb_step(const KVf& f, const bf16x8 (&qf)[4], f32x16 (&o)[2], float& c_run, int r32, int hi) {
    const f32x16 s = qk_tile(f, qf);
    float z[16], r[16];
#pragma unroll
    for (int i = 0; i < 16; ++i) { z[i] = s[i] * SC2; const float e = __builtin_amdgcn_exp2f(-__builtin_fabsf(z[i]));
        float sp = __builtin_fmaxf(z[i], 0.f) + __builtin_amdgcn_logf(1.0f + e);
        if (DIAG) { const int kk = 8 * (i >> 2) + 4 * hi + (i & 3); if (!(kk < r32)) sp = 0.f; }
        r[i] = sp; }
    float G[4], Gp[4];
#pragma unroll
    for (int g = 0; g < 4; ++g) { r[4 * g + 2] += r[4 * g + 3]; r[4 * g + 1] += r[4 * g + 2]; r[4 * g] += r[4 * g + 1]; G[g] = r[4 * g]; }
#pragma unroll
    for (int g = 0; g < 4; ++g) Gp[g] = __shfl_xor(G[g], 32);
    float off[4]; float above = c_run;
#pragma unroll
    for (int g = 3; g >= 0; --g) { off[g] = above + (hi == 0 ? Gp[g] : 0.f); above += (G[g] + Gp[g]); }
    c_run = above;
    float w[16];
#pragma unroll
    for (int i = 0; i < 16; ++i) { float wv = __builtin_amdgcn_exp2f(z[i] - (r[i] + off[i >> 2]));
        if (DIAG) { const int kk = 8 * (i >> 2) + 4 * hi + (i & 3); if (!(kk < r32)) wv = 0.f; }
        w[i] = wv; }
    pv_tile(o, f, w);
}
__device__ __forceinline__ void swa_step(const KVf& f, const bf16x8 (&qf)[4], f32x16 (&o)[2], float& m_run, float& l_run, float slope2, int dist0  , int hi) {
    const f32x16 s = qk_tile(f, qf);
    float sc[16]; float mx = -1e30f;
#pragma unroll
    for (int i = 0; i < 16; ++i) { const int dist = dist0 - (8 * (i >> 2) + 4 * hi + (i & 3)); const bool valid = (unsigned)dist < 128u;
        sc[i] = valid ? s[i] * SC2 - slope2 * (float)dist : -1e30f; mx = __builtin_fmaxf(mx, sc[i]); }
    mx = __builtin_fmaxf(mx, __shfl_xor(mx, 32));
    const float m_new = __builtin_fmaxf(m_run, mx); const float al = __builtin_amdgcn_exp2f(m_run - m_new); m_run = m_new;
    float w[16]; float ls = 0.f;
#pragma unroll
    for (int i = 0; i < 16; ++i) { w[i] = __builtin_amdgcn_exp2f(sc[i] - m_new); ls += w[i]; }
    l_run = l_run * al + ls;
#pragma unroll
    for (int dt = 0; dt < 2; ++dt)
#pragma unroll
        for (int i = 0; i < 16; ++i) o[dt][i] *= al;
    pv_tile(o, f, w);
}
constexpr int STG_PITCH = 516;
__device__ __forceinline__ void finish_unit(const f32x16 (&o)[2], float scale, float* stage, int wave, int lane, size_t row0, const float* __restrict__ gn, bf16* MIXED, int goff) {
    const int r32 = lane & 31, hi = lane >> 5;
#pragma unroll
    for (int dt = 0; dt < 2; ++dt)
#pragma unroll
        for (int g = 0; g < 4; ++g) { f32x4 v = {o[dt][4 * g] * scale, o[dt][4 * g + 1] * scale, o[dt][4 * g + 2] * scale, o[dt][4 * g + 3] * scale};
            *(f32x4*)(stage + r32 * STG_PITCH + wave * 64 + 32 * dt + 8 * g + 4 * hi) = v; }
    __syncthreads();
    const f32x4 g0 = *(const f32x4*)(gn + 8 * lane), g1 = *(const f32x4*)(gn + 8 * lane + 4);
#pragma unroll
    for (int qq = 0; qq < 4; ++qq) { const int q = wave * 4 + qq; const f32x4 a = *(const f32x4*)(stage + q * STG_PITCH + 8 * lane), b = *(const f32x4*)(stage + q * STG_PITCH + 8 * lane + 4);
        float ss = (a.x * a.x + a.y * a.y) + (a.z * a.z + a.w * a.w) + (b.x * b.x + b.y * b.y) + (b.z * b.z + b.w * b.w);
        const float rs = 1.0f / sqrtf(wave_sum(ss) * (1.0f / 512.0f) + 1e-6f);
        const f32x4 ya = a * rs * g0, yb = b * rs * g1; v4u w; w.x = pk2(ya.x, ya.y); w.y = pk2(ya.z, ya.w); w.z = pk2(yb.x, yb.y); w.w = pk2(yb.z, yb.w);
        *(v4u*)(MIXED + (row0 + q) * D + goff + 8 * lane) = w; }
    __syncthreads();
}
__device__ __forceinline__ void phase_attention(const Ptrs& P, unsigned char* lds, int lane, int wave) {
    const bf16* PROJ = (const bf16*)(P.ws + WS_PROJ); const bf16* VT = (const bf16*)(P.ws + WS_VT); bf16* MIXED = (bf16*)(P.ws + WS_MIXED);
    float* stage = (float*)lds; const int r32 = lane & 31, hi = lane >> 5;
    for (int idx = blockIdx.x; idx < 1024; idx += gridDim.x) {
        const int grp = idx >> 9, tile = idx & 511; const int b = tile >> 8, q0 = (tile & 255) * 32; const size_t rowbase = (size_t)b * SEQ;
        f32x16 o[2]; o[0] = f32x16{}; o[1] = f32x16{}; bf16x8 qf[4]; KVf cur, nxt;
        if (grp == 0) {
            const bf16* Qp = PROJ + (rowbase + q0 + r32) * NQK + wave * 64 + 8 * hi;
#pragma unroll
            for (int d0 = 0; d0 < 4; ++d0) qf[d0] = *(const bf16x8*)(Qp + 16 * d0);
            const bf16* Kp = PROJ + (size_t)r32 * NQK + 512 + wave * 64 + 8 * hi; const bf16* Vp = VT + (wave * 64 + r32) * 32 + 4 * hi;
            float c_run = 0.f;
            load_kv(cur, Kp, Vp, rowbase + q0);
            if (q0 >= 32) load_kv(nxt, Kp, Vp, rowbase + q0 - 32);
            sb_step<true>(cur, qf, o, c_run, r32, hi);
            for (int k0 = q0 - 32; k0 >= 0; k0 -= 32) {
                if (__all(c_run >= SB_STOP)) break;
                cur = nxt;
                if (k0 >= 32) load_kv(nxt, Kp, Vp, rowbase + k0 - 32);
                sb_step<false>(cur, qf, o, c_run, r32, hi);
            }
            finish_unit(o, 1.0f, stage, wave, lane, rowbase + q0, P.gn_sb, MIXED, 0);
        } else {
            const int kvh = wave >> 2; const float slope2 = exp2f(-(float)(wave + 1)) * LOG2E;
            const bf16* Qp = PROJ + (rowbase + q0 + r32) * NQK + 1024 + wave * 64 + 8 * hi;
#pragma unroll
            for (int d0 = 0; d0 < 4; ++d0) qf[d0] = *(const bf16x8*)(Qp + 16 * d0);
            const bf16* Kp = PROJ + (size_t)r32 * NQK + 1536 + kvh * 64 + 8 * hi; const bf16* Vp = VT + (512 + kvh * 64 + r32) * 32 + 4 * hi;
            float m_run = P.sinks[wave] * LOG2E, l_run = (hi == 0) ? 1.0f : 0.0f;
            const int kfirst = q0 >= 128 ? q0 - 128 : 0;
            load_kv(cur, Kp, Vp, rowbase + kfirst);
            for (int k0 = kfirst; k0 <= q0; k0 += 32) {
                if (k0 + 32 <= q0) load_kv(nxt, Kp, Vp, rowbase + k0 + 32);
                swa_step(cur, qf, o, m_run, l_run, slope2, q0 + r32 - k0, hi);
                cur = nxt;
            }
            const float l = l_run + __shfl_xor(l_run, 32);
            finish_unit(o, 1.0f / l, stage, wave, lane, rowbase + q0, P.gn_swa, MIXED, 512);
        }
    }
}

#ifndef MK_DUP
#define MK_DUP (-1)
#endif
struct Args { const float* in[16]; float* out; unsigned char* ws; int ph_lo, ph_hi; };
constexpr int NPHASE = 9;
template <int K> __device__ __forceinline__ void run_phase(const Ptrs& P, unsigned char* lds, int tid, int lane, int wave) {
    unsigned char* ws = P.ws; const int G = gridDim.x, c = blockIdx.x;
    PG8_LAS unsigned char* glds = (PG8_LAS unsigned char*)lds;
    if constexpr (K == 0) phase_weights(P, lds, tid, lane, wave);
    if constexpr (K == 1) phase_mod_rows(P, lane, wave);
    if constexpr (K == 2) {
        { pg8::Gemm g{(const bf16*)(ws + WS_XN), (const bf16*)(ws + WS_WQK), M, NQK, D}; pg8::StaticOrder S; S.init(M, NQK, G, c);
          pg8::EpiBf16<0> E{(bf16*)(ws + WS_PROJ), NQK, (const float*)(ws + WS_BQK), 0, 0, 1.f};
          pg8::gemm_phase<pg8::EpiBf16<0>, pg8::StaticOrder, true, true>(glds, g, S, E); }
        { pg8::Gemm g{(const bf16*)(ws + WS_WV), (const bf16*)(ws + WS_XN), NVT, M, D}; pg8::StaticOrder S; S.init(NVT, M, G, G - 1 - c);
          pg8::EpiVt E{(bf16*)(ws + WS_VT), M, (const float*)(ws + WS_BVT)};
          pg8::gemm_phase<pg8::EpiVt, pg8::StaticOrder, true, true>(glds, g, S, E); }
    }
    if constexpr (K == 3) phase_attention(P, lds, lane, wave);
    if constexpr (K == 4) {
        pg8::Gemm g{(const bf16*)(ws + WS_MIXED), (const bf16*)(ws + WS_WOUT), M, D, D}; pg8::StaticOrder S; S.init(M, D, G, c);
        pg8::EpiRes E{P.x, (float*)(ws + WS_Y), (const float*)(ws + WS_MOD) + 2 * D, DN_ALPHA};
        pg8::gemm_phase<pg8::EpiRes, pg8::StaticOrder, true, true>(glds, g, S, E);
    }
    if constexpr (K == 5) phase_ln_rows<true>(P, (const float*)(ws + WS_Y), P.ln1_g, P.ln1_b, P.out, lane, wave);
    if constexpr (K == 6) {
        pg8::Gemm g{(const bf16*)(ws + WS_XN), (const bf16*)(ws + WS_WGU), M, NGU, D}; pg8::StaticOrder S; S.init(M, NGU, G, c);
        pg8::EpiGU E{(bf16*)(ws + WS_HMID), DFF};
        pg8::gemm_phase<pg8::EpiGU, pg8::StaticOrder, true, true>(glds, g, S, E);
    }
    if constexpr (K == 7) {
        pg8::Gemm g{(const bf16*)(ws + WS_HMID), (const bf16*)(ws + WS_WDOWN), M, D, DFF}; pg8::StaticOrder S; S.init(M, D, G, c);
        pg8::EpiRes E{P.out, (float*)(ws + WS_Y), (const float*)(ws + WS_MOD) + 5 * D, DN_ALPHA};
        pg8::gemm_phase<pg8::EpiRes, pg8::StaticOrder, true, true>(glds, g, S, E);
    }
    if constexpr (K == 8) phase_ln_rows<false>(P, (const float*)(ws + WS_Y), P.ln2_g, P.ln2_b, P.out, lane, wave);
}
__global__ void __launch_bounds__(NWAVES * 64, 2) hymba_fwd(Args args) {
    extern __shared__ __attribute__((aligned(16))) unsigned char lds[];
    const int tid = threadIdx.x, lane = tid & 63, wave = __builtin_amdgcn_readfirstlane(tid >> 6);
    Ptrs P; P.x = args.in[0]; P.c = args.in[1]; P.w_ada = args.in[2]; P.b_ada = args.in[3]; P.w_in = args.in[4]; P.b_in = args.in[5]; P.sinks = args.in[6]; P.gn_sb = args.in[7];
    P.gn_swa = args.in[8]; P.w_out = args.in[9]; P.ln1_g = args.in[10]; P.ln1_b = args.in[11]; P.w_gu = args.in[12]; P.w_down = args.in[13]; P.ln2_g = args.in[14]; P.ln2_b = args.in[15];
    P.out = args.out; P.ws = args.ws;
    const int lo = args.ph_lo, hi = args.ph_hi;
    volatile LAS unsigned* bst = (volatile LAS unsigned*)((LAS unsigned char*)lds + BAR_LDS_OFF);
    if (tid < 4) bst[tid] = 0u;
    __syncthreads();
    XcdBarrier bar = xcd_barrier_post((unsigned*)(args.ws + WS_BAR), bst);
    if (lo < 0) cg::this_grid().sync();
#define IN(k) (lo <= (k) && (k) < hi)
#define PHASE(k) do { if (IN(k)) { run_phase<k>(P, lds, tid, lane, wave); if (MK_DUP == (k)) { xcd_barrier(bar); run_phase<k>(P, lds, tid, lane, wave); } \
                      if (IN((k) + 1)) xcd_barrier(bar); } } while (0)
    PHASE(0); PHASE(1); PHASE(2); PHASE(3); PHASE(4); PHASE(5); PHASE(6); PHASE(7); PHASE(8);
#undef IN
#undef PHASE
}

extern "C" void kernel_launch(void* const* d_in, const int* in_sizes, int n_in, void* d_out, int out_size, void* d_ws, size_t ws_size, hipStream_t stream) {
    static int grid = 0;
    if (grid == 0) {
        if (n_in != 16 || in_sizes[0] != M * D || out_size != M * D || ws_size < WS_END) { fprintf(stderr, "kernel_launch: unexpected shapes (n_in %d, in0 %d, out %d, ws %zu)\n", n_in, n_in > 0 ? in_sizes[0] : -1, out_size, ws_size); grid = -1; return; }
        int dev = 0, cus = 0, per_cu = 0;
        (void)hipGetDevice(&dev); (void)hipDeviceGetAttribute(&cus, hipDeviceAttributeMultiprocessorCount, dev);
        if (hipFuncSetAttribute((const void*)hymba_fwd, hipFuncAttributeMaxDynamicSharedMemorySize, LDS_BYTES) != hipSuccess) { fprintf(stderr, "kernel_launch: hipFuncSetAttribute failed\n"); grid = -1; return; }
        if (hipOccupancyMaxActiveBlocksPerMultiprocessor(&per_cu, (const void*)hymba_fwd, NWAVES * 64, LDS_BYTES) != hipSuccess || per_cu < 1) { fprintf(stderr, "kernel_launch: occupancy query says %d\n", per_cu); per_cu = 1; }
        (void)hipGetLastError();
        grid = cus * per_cu;
    }
    if (grid < 0) return;
    (void)hipMemsetAsync((unsigned char*)d_ws + WS_BAR, 0, BAR_BYTES, stream);
    Args a{};
    for (int i = 0; i < 16; ++i) a.in[i] = (const float*)d_in[i];
    a.out = (float*)d_out; a.ws = (unsigned char*)d_ws;
#if MK_COOP
    a.ph_lo = 0; a.ph_hi = NPHASE;
    void* kargs[] = {&a};
    hipError_t e = hipLaunchCooperativeKernel((const void*)hymba_fwd, dim3(grid), dim3(NWAVES * 64), kargs, LDS_BYTES, stream);
    if (e != hipSuccess) fprintf(stderr, "cooperative launch failed: %s (grid %d)\n", hipGetErrorString(e), grid);
#else
    for (int ph = 0; ph < NPHASE; ++ph) { a.ph_lo = ph; a.ph_hi = ph + 1; hipLaunchKernelGGL(hymba_fwd, dim3(grid), dim3(NWAVES * 64), LDS_BYTES, stream, a); }
#endif
}
```
